# Optimizing an MI355X kernel written in HIP

```python
import math
import jax, jax.numpy as jnp
from jax import lax
import numpy as np

D_MODEL = 1024
BATCH = 4
SEQ = 8192
DEPTH = 1
DEC_BATCH = 32
DEC_SEQ = 2048
PAST_LEN = 128

N_MEM = 256
DA_HEADS = 8
DA_HEAD_DIM = 64
DA_Q_WIDTH = DA_HEADS * 2 * DA_HEAD_DIM
DA_V_WIDTH = DA_HEADS * 2 * DA_HEAD_DIM
ROT_DIM = DA_HEAD_DIM // 4
ROPE_THETA = 500000.0
Q_BLOCK = 128
SUBLN_EPS = 1e-5
LRU_WIDTH = 1024
LRU_BLOCKS = 8
LRU_BLOCK_DIM = LRU_WIDTH // LRU_BLOCKS
CONV_WIDTH = 4
CONV_PAD_LEFT = 2
LRU_C = 8.0
IN_SPLITS = (DA_Q_WIDTH,
             2 * DA_Q_WIDTH,
             2 * DA_Q_WIDTH + DA_V_WIDTH,
             2 * DA_Q_WIDTH + DA_V_WIDTH + LRU_WIDTH,
             2 * DA_Q_WIDTH + DA_V_WIDTH + 2 * LRU_WIDTH,
             2 * DA_Q_WIDTH + DA_V_WIDTH + 2 * LRU_WIDTH + D_MODEL)
IN_WIDTH = 2 * DA_Q_WIDTH + DA_V_WIDTH + 2 * LRU_WIDTH + 2 * D_MODEL
XA_HEADS = 4
XA_HEAD_DIM = D_MODEL // XA_HEADS
D_FF = ((8 * D_MODEL + 3 * 256 - 1) // (3 * 256)) * 256
DEEPNORM_ALPHA = (2.0 * DEPTH) ** 0.25
DEEPNORM_BETA = (8.0 * DEPTH) ** -0.25
LN_EPS = 1e-5

kernel_name = "hybrid_diffattn_rglru_encoder"


def layer_norm(x, g, b):
    xf = x.astype(jnp.float32)
    mu = jnp.mean(xf, axis=-1, keepdims=True)
    xc = xf - mu
    var = jnp.mean(xc * xc, axis=-1, keepdims=True)
    y = xc * lax.rsqrt(var + LN_EPS) * g.astype(jnp.float32) + b.astype(jnp.float32)
    return y.astype(x.dtype)


def rope_tables(T):
    inv = ROPE_THETA ** (-jnp.arange(0, ROT_DIM, 2, dtype=jnp.float32) / ROT_DIM)
    ang = jnp.arange(T, dtype=jnp.float32)[:, None] * inv[None, :]
    return jnp.cos(ang), jnp.sin(ang)


def apply_partial_rope(x, cos, sin):
    xr = x[..., :ROT_DIM].astype(jnp.float32)
    half = ROT_DIM // 2
    x1, x2 = xr[..., :half], xr[..., half:]
    c = cos[None, :, None, None, :]
    s = sin[None, :, None, None, :]
    rot = jnp.concatenate([x1 * c - x2 * s, x2 * c + x1 * s], axis=-1).astype(x.dtype)
    return jnp.concatenate([rot, x[..., ROT_DIM:]], axis=-1)


def diff_attention(q, k, v, lam):
    B, T = q.shape[0], q.shape[1]
    nblk = T // Q_BLOCK
    scale = DA_HEAD_DIM ** -0.5
    qb = (q * scale).reshape(B, nblk, Q_BLOCK, DA_HEADS, 2, DA_HEAD_DIM).transpose(1, 0, 2, 3, 4, 5)

    def one_block(qblk):
        s = jnp.einsum('bqhcd,bkhcd->bhcqk', qblk, k).astype(jnp.float32)
        p = jax.nn.softmax(s, axis=-1)
        p = p[:, :, 0] - lam * p[:, :, 1]
        return jnp.einsum('bhqk,bkhe->bqhe', p.astype(v.dtype), v)

    o = lax.map(one_block, qb)
    return o.transpose(1, 0, 2, 3, 4).reshape(B, T, DA_HEADS, 2 * DA_HEAD_DIM)


def centred_conv(x, w, b):
    T = x.shape[1]
    xp = jnp.pad(x, ((0, 0), (CONV_PAD_LEFT, CONV_WIDTH - 1 - CONV_PAD_LEFT), (0, 0)))
    out = xp[:, 0:T] * w[0]
    for j in range(1, CONV_WIDTH):
        out = out + xp[:, j:j + T] * w[j]
    return out + b


def block_diag(x, w, b):
    xb = x.reshape(x.shape[:-1] + (LRU_BLOCKS, LRU_BLOCK_DIM))
    y = jnp.einsum('btnd,nde->btne', xb, w).reshape(x.shape)
    return y + b


def lin_scan_combine(c1, c2):
    a1, b1 = c1
    a2, b2 = c2
    return a1 * a2, a2 * b1 + b2


def rg_lru_direction(x, w_a, b_a, w_x, b_x, a_param, reverse):
    T = x.shape[1]
    r = jax.nn.sigmoid(block_diag(x, w_a, b_a).astype(jnp.float32))
    i = jax.nn.sigmoid(block_diag(x, w_x, b_x).astype(jnp.float32))
    log_a = -LRU_C * r * jax.nn.softplus(-a_param.astype(jnp.float32))
    a = jnp.exp(log_a)
    mult = jnp.sqrt(-jnp.expm1(2.0 * log_a))
    start = T - 1 if reverse else 0
    is_start = (jnp.arange(T) == start)[None, :, None]
    mult = jnp.where(is_start, 1.0, mult)
    u = mult * i * x.astype(jnp.float32)
    _, h = lax.associative_scan(lin_scan_combine, (a, u), reverse=reverse, axis=1)
    return h


def mixer(x, w_in, lambda_q1, lambda_k1, lambda_q2, lambda_k2, subln_g, conv_w, conv_b,
          lru_wa, lru_ba, lru_wx, lru_bx, lru_a, p_attn, p_lru, w_mix_out, lambda_init):
    B, T, _ = x.shape
    proj = x @ w_in
    q, k, v, xr, yr, g_attn, g_lru = jnp.split(proj, IN_SPLITS, axis=-1)

    cos, sin = rope_tables(T)
    q = apply_partial_rope(q.reshape(B, T, DA_HEADS, 2, DA_HEAD_DIM), cos, sin)
    k = apply_partial_rope(k.reshape(B, T, DA_HEADS, 2, DA_HEAD_DIM), cos, sin)
    v = v.reshape(B, T, DA_HEADS, 2 * DA_HEAD_DIM)
    f32 = jnp.float32
    lam = (jnp.exp(jnp.sum(lambda_q1.astype(f32) * lambda_k1.astype(f32)))
           - jnp.exp(jnp.sum(lambda_q2.astype(f32) * lambda_k2.astype(f32))) + lambda_init)
    o = diff_attention(q, k, v, lam).astype(f32)
    o = o * lax.rsqrt(jnp.mean(o * o, axis=-1, keepdims=True) + SUBLN_EPS) * subln_g.astype(f32)
    attn_out = (o * (1.0 - lambda_init)).reshape(B, T, DA_V_WIDTH).astype(x.dtype)

    xc = centred_conv(xr, conv_w, conv_b)
    h = (rg_lru_direction(xc, lru_wa[0], lru_ba[0], lru_wx[0], lru_bx[0], lru_a[0], False)
         + rg_lru_direction(xc, lru_wa[1], lru_ba[1], lru_wx[1], lru_bx[1], lru_a[1], True))
    lru_out = (h * jax.nn.gelu(yr.astype(f32))).astype(x.dtype)

    merged = jax.nn.sigmoid(g_attn) * (attn_out @ p_attn) + jax.nn.sigmoid(g_lru) * (lru_out @ p_lru)
    return merged @ w_mix_out


def cross_attention(x, mem, xa_wq, xa_wkv, xa_wo):
    B, T, _ = x.shape
    M = mem.shape[1]
    q = (x @ xa_wq).reshape(B, T, XA_HEADS, XA_HEAD_DIM) * (XA_HEAD_DIM ** -0.5)
    k, v = jnp.split(mem @ xa_wkv, 2, axis=-1)
    k = k.reshape(B, M, XA_HEADS, XA_HEAD_DIM)
    v = v.reshape(B, M, XA_HEADS, XA_HEAD_DIM)
    s = jnp.einsum('bqhd,bkhd->bhqk', q, k).astype(jnp.float32)
    p = jax.nn.softmax(s, axis=-1)
    o = jnp.einsum('bhqk,bkhd->bqhd', p.astype(v.dtype), v).reshape(B, T, D_MODEL)
    return o @ xa_wo


def swiglu(x, ffn_w_in, ffn_w_out):
    g, u = jnp.split(x @ ffn_w_in, 2, axis=-1)
    return (jax.nn.silu(g) * u) @ ffn_w_out


def encoder_layer(x, mem, layer_idx, w_in, lambda_q1, lambda_k1, lambda_q2, lambda_k2, subln_g,
                  conv_w, conv_b, lru_wa, lru_ba, lru_wx, lru_bx, lru_a, p_attn, p_lru, w_mix_out,
                  ln1_g, ln1_b, xa_wq, xa_wkv, xa_wo, ln2_g, ln2_b, ffn_w_in, ffn_w_out, ln3_g, ln3_b):
    lambda_init = 0.8 - 0.6 * math.exp(-0.3 * layer_idx)
    m = mixer(x, w_in, lambda_q1, lambda_k1, lambda_q2, lambda_k2, subln_g, conv_w, conv_b,
              lru_wa, lru_ba, lru_wx, lru_bx, lru_a, p_attn, p_lru, w_mix_out, lambda_init)
    x = layer_norm(DEEPNORM_ALPHA * x + m, ln1_g, ln1_b)
    x = layer_norm(DEEPNORM_ALPHA * x + cross_attention(x, mem, xa_wq, xa_wkv, xa_wo), ln2_g, ln2_b)
    x = layer_norm(DEEPNORM_ALPHA * x + swiglu(x, ffn_w_in, ffn_w_out), ln3_g, ln3_b)
    return x


def trunk(x, mem, weights):
    for l in range(DEPTH):
        layer_w = [w[l] for w in weights]
        x = encoder_layer(x, mem, l, *layer_w)
    return x


def setup_inputs(seed: int = 0) -> dict:
    key = jax.random.key(seed)
    ks = jax.random.split(key, 40)
    f32 = jnp.float32

    def nrm(k, shape, scale):
        return jax.random.normal(k, shape, f32) * scale

    def gain(k, shape):
        return 1.0 + 0.02 * jax.random.normal(k, shape, f32)

    a0 = jax.random.uniform(ks[16], (DEPTH, 2, LRU_WIDTH), f32, 0.9, 0.999)
    s0 = a0 ** (1.0 / LRU_C)
    lru_a = jnp.log(s0) - jnp.log1p(-s0)

    return {
        "x_prompt": nrm(ks[0], (BATCH, SEQ, D_MODEL), 1.0),
        "x_sample": nrm(ks[1], (DEC_BATCH, DEC_SEQ, D_MODEL), 1.0),
        "mem_prompt": nrm(ks[2], (BATCH, N_MEM, D_MODEL), 1.0),
        "mem_sample": nrm(ks[3], (DEC_BATCH, N_MEM, D_MODEL), 1.0),
        "w_in": nrm(ks[4], (DEPTH, D_MODEL, IN_WIDTH), D_MODEL ** -0.5),
        "lambda_q1": nrm(ks[5], (DEPTH, DA_HEAD_DIM), 0.1),
        "lambda_k1": nrm(ks[6], (DEPTH, DA_HEAD_DIM), 0.1),
        "lambda_q2": nrm(ks[7], (DEPTH, DA_HEAD_DIM), 0.1),
        "lambda_k2": nrm(ks[8], (DEPTH, DA_HEAD_DIM), 0.1),
        "subln_g": gain(ks[9], (DEPTH, 2 * DA_HEAD_DIM)),
        "conv_w": nrm(ks[10], (DEPTH, CONV_WIDTH, LRU_WIDTH), CONV_WIDTH ** -0.5),
        "conv_b": nrm(ks[11], (DEPTH, LRU_WIDTH), 0.02),
        "lru_wa": nrm(ks[12], (DEPTH, 2, LRU_BLOCKS, LRU_BLOCK_DIM, LRU_BLOCK_DIM), LRU_BLOCK_DIM ** -0.5),
        "lru_ba": nrm(ks[13], (DEPTH, 2, LRU_WIDTH), 0.02),
        "lru_wx": nrm(ks[14], (DEPTH, 2, LRU_BLOCKS, LRU_BLOCK_DIM, LRU_BLOCK_DIM), LRU_BLOCK_DIM ** -0.5),
        "lru_bx": nrm(ks[15], (DEPTH, 2, LRU_WIDTH), 0.02),
        "lru_a": lru_a,
        "p_attn": nrm(ks[17], (DEPTH, DA_V_WIDTH, D_MODEL), DA_V_WIDTH ** -0.5),
        "p_lru": nrm(ks[18], (DEPTH, LRU_WIDTH, D_MODEL), LRU_WIDTH ** -0.5),
        "w_mix_out": nrm(ks[19], (DEPTH, D_MODEL, D_MODEL), DEEPNORM_BETA * D_MODEL ** -0.5),
        "ln1_g": gain(ks[20], (DEPTH, D_MODEL)),
        "ln1_b": nrm(ks[21], (DEPTH, D_MODEL), 0.02),
        "xa_wq": nrm(ks[22], (DEPTH, D_MODEL, D_MODEL), D_MODEL ** -0.5),
        "xa_wkv": nrm(ks[23], (DEPTH, D_MODEL, 2 * D_MODEL), D_MODEL ** -0.5),
        "xa_wo": nrm(ks[24], (DEPTH, D_MODEL, D_MODEL), DEEPNORM_BETA * D_MODEL ** -0.5),
        "ln2_g": gain(ks[25], (DEPTH, D_MODEL)),
        "ln2_b": nrm(ks[26], (DEPTH, D_MODEL), 0.02),
        "ffn_w_in": nrm(ks[27], (DEPTH, D_MODEL, 2 * D_FF), D_MODEL ** -0.5),
        "ffn_w_out": nrm(ks[28], (DEPTH, D_FF, D_MODEL), DEEPNORM_BETA * D_FF ** -0.5),
        "ln3_g": gain(ks[29], (DEPTH, D_MODEL)),
        "ln3_b": nrm(ks[30], (DEPTH, D_MODEL), 0.02),
    }


def reference(x_prompt, x_sample, mem_prompt, mem_sample, w_in, lambda_q1, lambda_k1, lambda_q2,
              lambda_k2, subln_g, conv_w, conv_b, lru_wa, lru_ba, lru_wx, lru_bx, lru_a, p_attn, p_lru,
              w_mix_out, ln1_g, ln1_b, xa_wq, xa_wkv, xa_wo, ln2_g, ln2_b, ffn_w_in, ffn_w_out,
              ln3_g, ln3_b):
    weights = (w_in, lambda_q1, lambda_k1, lambda_q2, lambda_k2, subln_g, conv_w, conv_b,
               lru_wa, lru_ba, lru_wx, lru_bx, lru_a, p_attn, p_lru, w_mix_out,
               ln1_g, ln1_b, xa_wq, xa_wkv, xa_wo, ln2_g, ln2_b, ffn_w_in, ffn_w_out, ln3_g, ln3_b)
    y_prompt = trunk(x_prompt, mem_prompt, weights)
    y_sample = trunk(x_sample, mem_sample, weights)
    return (y_prompt, y_sample)
```

```cpp
#include <hip/hip_runtime.h>
#include <hip/hip_cooperative_groups.h>
#include <cstdio>
#include <cstdint>
namespace cg = cooperative_groups;

#define LAS __attribute__((address_space(3)))
#define GAS __attribute__((address_space(1)))
typedef unsigned short bf16_t;
typedef short bf16x8 __attribute__((ext_vector_type(8)));
typedef short s16x4 __attribute__((ext_vector_type(4)));
typedef float f32x4 __attribute__((ext_vector_type(4)));
typedef float f32x2 __attribute__((ext_vector_type(2)));
typedef float f32x16 __attribute__((ext_vector_type(16)));
typedef unsigned u32x4 __attribute__((ext_vector_type(4)));
typedef unsigned u32x2 __attribute__((ext_vector_type(2)));

constexpr int DM = 1024, NTOK = 98304, RM = 32768, NROUND = 3, NMEMROW = 9216, DFF = 2816, INW = 7168;
constexpr float ALPHA = 1.189207115002721f;
constexpr float LN_EPS = 1e-5f, SUBLN_EPS = 1e-5f, LAMBDA_INIT = 0.2f;
constexpr int NWAVES = 8, NTHREADS = 512;
constexpr int LDS_BYTES = 147456, RING_BYTES = 131072, XLDS_OFF = RING_BYTES;

constexpr size_t MiB = 1u << 20;
constexpr size_t WS_CTL = 0, WS_ROPE = 1 * MiB;
constexpr size_t WS_WIN = 2 * MiB, WS_PATTN = 16 * MiB, WS_PLRU = 18 * MiB, WS_WMIX = 20 * MiB, WS_XAQ = 22 * MiB, WS_XAO = 24 * MiB, WS_XAKV = 26 * MiB;
constexpr size_t WS_FFIN = 30 * MiB, WS_FFOUT = 41 * MiB, WS_LRUW = 47 * MiB, WS_MEMB = 48 * MiB, WS_KX = 66 * MiB, WS_VXT = 84 * MiB, WS_XB = 104 * MiB;
constexpr size_t WS_Q = 296 * MiB, WS_K = 360 * MiB, WS_V = 424 * MiB, WS_XR = 488 * MiB, WS_GYR = 552 * MiB, WS_SA = 616 * MiB, WS_SL = 680 * MiB, WS_AOLO = 744 * MiB;
constexpr size_t SEG_STRIDE = 64 * MiB / 2;
constexpr size_t WS_MERGED = 296 * MiB, WS_TMP = 360 * MiB, WS_Y = 488 * MiB, WS_X1B = 872 * MiB, WS_QX = 936 * MiB, WS_P = 616 * MiB, WS_OXA = 680 * MiB;
constexpr size_t WS_X2B = 296 * MiB, WS_HFF = 744 * MiB, WS_LNX = 1000 * MiB, WS_END = 1002 * MiB;
constexpr int CW_QUEUE = 64;
constexpr int CW_LAM = 16;
constexpr int CW_BAR = 4096;
constexpr size_t CTL_ZERO_BYTES = 131072;
constexpr int CW_LNCNT = 8192;

__device__ __forceinline__ unsigned cvt_pk_bf16(float lo, float hi) { unsigned r; asm volatile("v_cvt_pk_bf16_f32 %0, %1, %2" : "=v"(r) : "v"(lo), "v"(hi)); return r; }
__device__ __forceinline__ float bf2f(unsigned short b) { return __uint_as_float(((unsigned)b) << 16); }
__device__ __forceinline__ float sigmoidf_(float x) { return __builtin_amdgcn_rcpf(1.f + __builtin_amdgcn_exp2f(-1.4426950408889634f * x)); }
__device__ __forceinline__ float gelu_tanh(float x) { const float u = 0.7978845608028654f * (x + 0.044715f * x * x * x); return x * sigmoidf_(2.f * u); }
__device__ __forceinline__ float wave_sum(float v) {
#pragma unroll
    for (int o = 1; o < 64; o <<= 1) v += __shfl_xor(v, o);
    return v;
}

namespace pg8 {
constexpr int BM = 256, BK = 64, HALF = 128, HTB = HALF * BK * 2, STAGE_BYTES = 8 * HTB, NXCD = 8, WGM = 8;
__host__ __device__ __forceinline__ int lds_byte(int r, int c) { const int st = (r >> 4) * 2 + (c >> 5), rr = r & 15, cc = c & 31, ob = rr * 64 + cc * 2; return st * 1024 + (ob ^ (((ob >> 9) & 1) << 5)); }
__host__ __device__ __forceinline__ void stage_rc(int b, int& R, int& C) { const int st = b / 1024, sb = b % 1024, swz = sb ^ (((sb >> 9) & 1) << 5); R = (st >> 1) * 16 + swz / 64; C = (st & 1) * 32 + (swz % 64) / 2; }
__host__ __device__ __forceinline__ int perm32(int rho) { const int n = rho >> 4, i = rho & 15; return 8 * (i >> 2) + 4 * n + (i & 3); }

struct Unit { int pm, pn; };
struct Gemm { const bf16_t* A; const bf16_t* Bt; int lda, ldb, K; };

struct StaticOrder {
    int nM, nN, nwg, G, c;
    __device__ void init(int M, int N, int G_, int c_) { nM = M / BM; nN = N / BM; nwg = nM * nN; G = G_; c = c_; }
    __device__ bool next(int i, Unit& u) const {
        const long L = (long)i * G + c; if (L >= nwg) return false;
        int wgid = (int)L; { const int q = nwg / NXCD, r = nwg % NXCD, xcd = wgid % NXCD, off = wgid / NXCD; wgid = (xcd < r ? xcd * (q + 1) : r * (q + 1) + (xcd - r) * q) + off; }
        const int nig = WGM * nN, gid = wgid / nig, fm = gid * WGM, gsz = (nM - fm) < WGM ? (nM - fm) : WGM;
        u.pm = fm + ((wgid % nig) % gsz); u.pn = (wgid % nig) / gsz; return true;
    }
    __device__ __forceinline__ const char* a_base(const Gemm& g, const Unit& u) const { return (const char*)(g.A + (size_t)u.pm * BM * g.lda); }
    __device__ __forceinline__ const char* b_base(const Gemm& g, const Unit& u) const { return (const char*)(g.Bt + (size_t)u.pn * BM * g.ldb); }
};
template <int MODE> struct XaOrder {
    int nwg, G, c, tshift  , seq0;
    __device__ bool next(int i, Unit& u) const { const long L = (long)i * G + c; if (L >= nwg) return false; u.pm = (int)(L >> 2); u.pn = (int)(L & 3); return true; }
    __device__ __forceinline__ const char* a_base(const Gemm& g, const Unit& u) const { return (const char*)(g.A + (size_t)u.pm * BM * g.lda + u.pn * 256); }
    __device__ __forceinline__ const char* b_base(const Gemm& g, const Unit& u) const {
        const int sq = seq0 + (u.pm >> tshift);
        return MODE == 0 ? (const char*)(g.Bt + (size_t)sq * 256 * 1024 + u.pn * 256) : (const char*)(g.Bt + (size_t)(sq * 4 + u.pn) * 65536);
    }
};

struct PmPnOrder {
    int nwg, G, c;
    __device__ bool next(int i, Unit& u) const { const long L = (long)i * G + c; if (L >= nwg) return false; u.pm = (int)(L >> 2); u.pn = (int)(L & 3); return true; }
    __device__ __forceinline__ const char* a_base(const Gemm& g, const Unit& u) const { return (const char*)(g.A + (size_t)u.pm * BM * g.lda); }
    __device__ __forceinline__ const char* b_base(const Gemm& g, const Unit& u) const { return (const char*)(g.Bt + (size_t)u.pn * BM * g.ldb); }
};
template <bool HOOK = false, class Epi, class Sched>
__device__ __forceinline__ void gemm_phase(LAS unsigned char* lds, const Gemm g, const Sched& S, const Epi& E) {
    int tid = threadIdx.x; asm volatile("" : "+v"(tid));
    const int wid = __builtin_amdgcn_readfirstlane(tid >> 6), lane = tid & 63, wr = wid >> 2, wc = wid & 3, fr = lane & 15, fq = lane >> 4;
    int lda = g.lda, ldb = g.ldb, K = g.K; asm volatile("" : "+s"(lda), "+s"(ldb), "+s"(K));
    const int nt = K / BK;
    unsigned voffA[2], voffB[2];
#pragma unroll
    for (int i = 0; i < 2; ++i) { int R, C; stage_rc(tid * 16 + i * 8192, R, C); const int Rb = (R & ~31) + perm32(R & 31);
        voffA[i] = (unsigned)(R * lda + C) * 2u; voffB[i] = (unsigned)(Rb * ldb + C) * 2u; }
    const size_t kstep = (size_t)(BK * 2);
    const size_t hstA = (size_t)HALF * lda * 2, hstB = (size_t)HALF * ldb * 2;
    const unsigned ldsw = (unsigned)wid * 1024u;
    const int aoff = lds_byte(wr * 64 + fr, fq * 8), boff = lds_byte(wc * 32 + fr, fq * 8);
#define PG8_SA(b, h) (((b) * 2 + (h)) * HTB)
#define PG8_SB(b, h) ((4 + (b) * 2 + (h)) * HTB)
#define PG8_STAGE(bufoff, gbase, voff) do { _Pragma("unroll") for (int _i = 0; _i < 2; ++_i) \
        __builtin_amdgcn_global_load_lds((const unsigned*)((const char*)(gbase) + (voff)[_i]), (LAS unsigned*)(lds + (bufoff) + ldsw + _i * 8192), 16, 0, 0); } while (0)
#define PG8_LDA(dst, b, h) do { _Pragma("unroll") for (int m = 0; m < 4; ++m) _Pragma("unroll") for (int k = 0; k < 2; ++k) dst[m][k] = *(const LAS bf16x8*)(lds + PG8_SA(b, h) + aoff + m * 2048 + k * 1024); } while (0)
#define PG8_LDB(dst, b, h) do { _Pragma("unroll") for (int n = 0; n < 2; ++n) _Pragma("unroll") for (int k = 0; k < 2; ++k) dst[n][k] = *(const LAS bf16x8*)(lds + PG8_SB(b, h) + boff + n * 2048 + k * 1024); } while (0)
#define PG8_MMA(ai, bj, At, Bt) do { __builtin_amdgcn_s_setprio(1); _Pragma("unroll") for (int m = 0; m < 4; ++m) _Pragma("unroll") for (int n = 0; n < 2; ++n) _Pragma("unroll") for (int k = 0; k < 2; ++k) \
        acc[ai][bj][m][n] = __builtin_amdgcn_mfma_f32_16x16x32_bf16(Bt[n][k], At[m][k], acc[ai][bj][m][n], 0, 0, 0); __builtin_amdgcn_s_setprio(0); } while (0)
#define PG8_WAIT_V(n) asm volatile("s_waitcnt vmcnt(" #n ")" ::: "memory")
#define PG8_WAIT_L(n) asm volatile("s_waitcnt lgkmcnt(" #n ")" ::: "memory")
#define PG8_BAR __builtin_amdgcn_s_barrier()
#define PG8_SCHED __builtin_amdgcn_sched_barrier(0)
    Unit cur, nxt; int ui = 0;
    if (!S.next(0, cur)) return;
    f32x4 acc[2][2][4][2];
#pragma unroll
    for (int a = 0; a < 2; ++a)
#pragma unroll
        for (int b = 0; b < 2; ++b)
#pragma unroll
            for (int m = 0; m < 4; ++m)
#pragma unroll
                for (int n = 0; n < 2; ++n) acc[a][b][m][n] = (f32x4){0.f, 0.f, 0.f, 0.f};
    bf16x8 At[4][2], B0[2][2], B1[2][2];
    const char* cA = S.a_base(g, cur); const char* cB = S.b_base(g, cur);
    PG8_STAGE(PG8_SB(0, 0), cB, voffB); PG8_STAGE(PG8_SB(0, 1), cB + hstB, voffB); PG8_STAGE(PG8_SA(0, 0), cA, voffA); PG8_STAGE(PG8_SA(0, 1), cA + hstA, voffA);
    if (wr == 1) PG8_BAR;
    PG8_WAIT_V(2); PG8_BAR;
    PG8_STAGE(PG8_SB(1, 0), cB + kstep, voffB); PG8_STAGE(PG8_SA(1, 0), cA + kstep, voffA); PG8_STAGE(PG8_SB(1, 1), cB + hstB + kstep, voffB);
    PG8_WAIT_V(6); PG8_BAR;
    for (;;) {
        const bool has_next = S.next(ui + 1, nxt);
        const char* nA = has_next ? S.a_base(g, nxt) : cA; const char* nB = has_next ? S.b_base(g, nxt) : cB;
        for (int t = 0; t < nt; t += 2) {
            if constexpr (HOOK) { if (t == (nt >> 1)) { E.mid(acc, cur, wr, wc, fr, fq); PG8_WAIT_V(0); } }
            const bool last = (t == nt - 2);
            const char* a1 = cA + (size_t)(t + 1) * kstep;
            const char* a2 = last ? nA : cA + (size_t)(t + 2) * kstep; const char* b2 = last ? nB : cB + (size_t)(t + 2) * kstep;
            const char* a3 = a2 + kstep; const char* b3 = b2 + kstep;
            PG8_LDB(B0, 0, 0); PG8_LDB(B1, 0, 1); PG8_SCHED; PG8_LDA(At, 0, 0); PG8_STAGE(PG8_SA(1, 1), a1 + hstA, voffA);
            PG8_WAIT_V(8); PG8_WAIT_L(0); PG8_BAR; PG8_MMA(0, 0, At, B0); PG8_MMA(0, 1, At, B1); PG8_BAR; PG8_SCHED;
            PG8_LDA(At, 0, 1); PG8_STAGE(PG8_SB(0, 0), b2, voffB); PG8_STAGE(PG8_SB(0, 1), b2 + hstB, voffB); PG8_STAGE(PG8_SA(0, 0), a2, voffA);
            PG8_WAIT_V(8); PG8_WAIT_L(0); PG8_BAR; PG8_MMA(1, 0, At, B0); PG8_MMA(1, 1, At, B1); PG8_BAR; PG8_SCHED;
            PG8_LDB(B0, 1, 0); PG8_LDB(B1, 1, 1); PG8_SCHED; PG8_LDA(At, 1, 0); PG8_STAGE(PG8_SA(0, 1), a2 + hstA, voffA);
            PG8_WAIT_V(8); PG8_WAIT_L(0); PG8_BAR; PG8_MMA(0, 0, At, B0); PG8_MMA(0, 1, At, B1); PG8_BAR; PG8_SCHED;
            PG8_LDA(At, 1, 1); PG8_STAGE(PG8_SB(1, 0), b3, voffB); PG8_STAGE(PG8_SB(1, 1), b3 + hstB, voffB); PG8_STAGE(PG8_SA(1, 0), a3, voffA);
            PG8_WAIT_V(8); PG8_WAIT_L(0); PG8_BAR; PG8_MMA(1, 0, At, B0); PG8_MMA(1, 1, At, B1); PG8_BAR; PG8_SCHED;
        }
        if (wr == 0) PG8_BAR;
        E(acc, cur, wr, wc, fr, fq);
        if (!has_next) break;
#pragma unroll
        for (int a = 0; a < 2; ++a)
#pragma unroll
            for (int b = 0; b < 2; ++b)
#pragma unroll
                for (int m = 0; m < 4; ++m)
#pragma unroll
                    for (int n = 0; n < 2; ++n) acc[a][b][m][n] = (f32x4){0.f, 0.f, 0.f, 0.f};
        cur = nxt; cA = nA; cB = nB; ++ui;
        if (wr == 1) PG8_BAR;
    }
    PG8_WAIT_V(0);
    PG8_BAR;
#undef PG8_SA
#undef PG8_SB
#undef PG8_STAGE
#undef PG8_LDA
#undef PG8_LDB
#undef PG8_MMA
#undef PG8_WAIT_V
#undef PG8_WAIT_L
#undef PG8_BAR
#undef PG8_SCHED
}

typedef f32x4 Acc[2][2][4][2];
__device__ __forceinline__ void st8(bf16_t* p, f32x4 v0, f32x4 v1) { u32x4 w; w.x = cvt_pk_bf16(v0[0], v0[1]); w.y = cvt_pk_bf16(v0[2], v0[3]); w.z = cvt_pk_bf16(v1[0], v1[1]); w.w = cvt_pk_bf16(v1[2], v1[3]); *(u32x4*)p = w; }

struct EpiProj {
    bf16_t* out; const float* rope; int tmask;
    __device__ __forceinline__ void operator()(const Acc& acc, const Unit& u, int wr, int wc, int fr, int fq) const {
        const int seg = u.pn >> 2, colt = (u.pn & 3) * 256;
        bf16_t* base = out + (size_t)seg * SEG_STRIDE;
        const bool do_rope = (seg < 2) && ((wc & 1) == 0);
#pragma unroll
        for (int ai = 0; ai < 2; ++ai)
#pragma unroll
            for (int m = 0; m < 4; ++m) {
                const int row = u.pm * BM + ai * HALF + wr * 64 + m * 16 + fr;
                f32x4 cs0, cs1, sn0, sn1;
                if (do_rope) { const float* rp = rope + (size_t)(row & tmask) * 16; cs0 = *(const f32x4*)rp; cs1 = *(const f32x4*)(rp + 4); sn0 = *(const f32x4*)(rp + 8); sn1 = *(const f32x4*)(rp + 12);
                    if (fq == 0) { sn0 = -sn0; sn1 = -sn1; } }
#pragma unroll
                for (int bj = 0; bj < 2; ++bj) {
                    f32x4 v0 = acc[ai][bj][m][0], v1 = acc[ai][bj][m][1];
                    if (seg < 2) {
                        if (do_rope) {
                            f32x4 p0, p1;
#pragma unroll
                            for (int j = 0; j < 4; ++j) { p0[j] = __shfl_xor(v0[j], 16); p1[j] = __shfl_xor(v1[j], 16); }
                            if (fq < 2) { v0 = v0 * cs0 + p0 * sn0; v1 = v1 * cs1 + p1 * sn1; }
                        }
                        if (seg == 0) { v0 = v0 * 0.18033688011112042f; v1 = v1 * 0.18033688011112042f; }
                    } else if (seg == 4) {
#pragma unroll
                        for (int j = 0; j < 4; ++j) { v0[j] = gelu_tanh(v0[j]); v1[j] = gelu_tanh(v1[j]); }
                    } else if (seg >= 5) {
#pragma unroll
                        for (int j = 0; j < 4; ++j) { v0[j] = sigmoidf_(v0[j]); v1[j] = sigmoidf_(v1[j]); }
                    }
                    st8(base + (size_t)row * 1024 + colt + bj * HALF + wc * 32 + 8 * fq, v0, v1);
                }
            }
    }
};
struct EpiKV {
    bf16_t* Kx; bf16_t* VxT;
    __device__ __forceinline__ void operator()(const Acc& acc, const Unit& u, int wr, int wc, int fr, int fq) const {
#pragma unroll
        for (int ai = 0; ai < 2; ++ai)
#pragma unroll
            for (int m = 0; m < 4; ++m) {
                const int row = u.pm * BM + ai * HALF + wr * 64 + m * 16 + fr;
#pragma unroll
                for (int bj = 0; bj < 2; ++bj) {
                    const f32x4 v0 = acc[ai][bj][m][0], v1 = acc[ai][bj][m][1];
                    const int col = u.pn * BM + bj * HALF + wc * 32 + 8 * fq;
                    if (u.pn < 4) st8(Kx + (size_t)row * 1024 + col, v0, v1);
                    else { const int c = col - 1024, h = c >> 8, dd = c & 255, key = row & 255, sq = row >> 8;
                        bf16_t* p = VxT + ((size_t)(sq * 4 + h) * 256 + dd) * 256 + key;
#pragma unroll
                        for (int j = 0; j < 4; ++j) { p[(size_t)j * 256] = (bf16_t)(cvt_pk_bf16(v0[j], 0.f) & 0xffffu); p[(size_t)(4 + j) * 256] = (bf16_t)(cvt_pk_bf16(v1[j], 0.f) & 0xffffu); } }
                }
            }
    }
};
__device__ __forceinline__ void unpack8(const u32x4 w, f32x4& a, f32x4& b) {
    a = (f32x4){__uint_as_float(w.x << 16), __uint_as_float(w.x & 0xffff0000u), __uint_as_float(w.y << 16), __uint_as_float(w.y & 0xffff0000u)};
    b = (f32x4){__uint_as_float(w.z << 16), __uint_as_float(w.z & 0xffff0000u), __uint_as_float(w.w << 16), __uint_as_float(w.w & 0xffff0000u)};
}
struct EpiGateCat {
    const bf16_t* sa; const bf16_t* sl; bf16_t* out;
    __device__ __forceinline__ static f32x4 ratio4(unsigned a01, unsigned a23, unsigned l01, unsigned l23) {
        f32x4 r;
        r[0] = __uint_as_float(a01 << 16) * __builtin_amdgcn_rcpf(fmaxf(__uint_as_float(l01 << 16), 8.6736174e-19f));
        r[1] = __uint_as_float(a01 & 0xffff0000u) * __builtin_amdgcn_rcpf(fmaxf(__uint_as_float(l01 & 0xffff0000u), 8.6736174e-19f));
        r[2] = __uint_as_float(a23 << 16) * __builtin_amdgcn_rcpf(fmaxf(__uint_as_float(l23 << 16), 8.6736174e-19f));
        r[3] = __uint_as_float(a23 & 0xffff0000u) * __builtin_amdgcn_rcpf(fmaxf(__uint_as_float(l23 & 0xffff0000u), 8.6736174e-19f));
        return r;
    }
    __device__ __forceinline__ void mid(Acc& acc, const Unit& u, int wr, int wc, int fr, int fq) const {
        const GAS bf16_t* sa = (const GAS bf16_t*)this->sa; const GAS bf16_t* sl = (const GAS bf16_t*)this->sl; asm volatile("" : "+s"(sa), "+s"(sl));
#pragma unroll
        for (int ai = 0; ai < 2; ++ai)
#pragma unroll
            for (int mp = 0; mp < 2; ++mp) {
                u32x4 wa[2][2], wl[2][2];
#pragma unroll
                for (int mm = 0; mm < 2; ++mm) { const int m = mp * 2 + mm; const int row = u.pm * BM + ai * HALF + wr * 64 + m * 16 + fr;
#pragma unroll
                    for (int bj = 0; bj < 2; ++bj) { const size_t off = (size_t)row * 1024 + u.pn * BM + bj * HALF + wc * 32 + 8 * fq;
                        wa[mm][bj] = *(const GAS u32x4*)(sa + off); wl[mm][bj] = *(const GAS u32x4*)(sl + off); } }
#pragma unroll
                for (int mm = 0; mm < 2; ++mm) { const int m = mp * 2 + mm;
#pragma unroll
                    for (int bj = 0; bj < 2; ++bj) {
                        acc[ai][bj][m][0] = acc[ai][bj][m][0] * ratio4(wa[mm][bj].x, wa[mm][bj].y, wl[mm][bj].x, wl[mm][bj].y);
                        acc[ai][bj][m][1] = acc[ai][bj][m][1] * ratio4(wa[mm][bj].z, wa[mm][bj].w, wl[mm][bj].z, wl[mm][bj].w);
                        asm volatile("" : "+v"(acc[ai][bj][m][0]), "+v"(acc[ai][bj][m][1]));
                    } }
                asm volatile("" ::: "memory");
            }
    }
    __device__ __forceinline__ void operator()(const Acc& acc, const Unit& u, int wr, int wc, int fr, int fq) const {
#pragma unroll
        for (int ai = 0; ai < 2; ++ai) {
            u32x4 wl[4][2];
#pragma unroll
            for (int m = 0; m < 4; ++m) { const int row = u.pm * BM + ai * HALF + wr * 64 + m * 16 + fr;
#pragma unroll
                for (int bj = 0; bj < 2; ++bj) wl[m][bj] = *(const u32x4*)(sl + (size_t)row * 1024 + u.pn * BM + bj * HALF + wc * 32 + 8 * fq); }
#pragma unroll
            for (int m = 0; m < 4; ++m) { const int row = u.pm * BM + ai * HALF + wr * 64 + m * 16 + fr;
#pragma unroll
                for (int bj = 0; bj < 2; ++bj) {
                    const size_t off = (size_t)row * 1024 + u.pn * BM + bj * HALF + wc * 32 + 8 * fq;
                    f32x4 l0, l1; unpack8(wl[m][bj], l0, l1);
#pragma unroll
                    for (int j = 0; j < 4; ++j) { l0[j] = fmaxf(l0[j], 8.6736174e-19f); l1[j] = fmaxf(l1[j], 8.6736174e-19f); }
                    st8(out + off, acc[ai][bj][m][0] * l0, acc[ai][bj][m][1] * l1);
                }
            }
            asm volatile("" ::: "memory");
        }
    }
};
struct EpiResid {
    const float* res; float* y;
    __device__ __forceinline__ void operator()(const Acc& acc, const Unit& u, int wr, int wc, int fr, int fq) const {
#pragma unroll
        for (int ai = 0; ai < 2; ++ai)
#pragma unroll
            for (int m = 0; m < 4; ++m) {
                const int row = u.pm * BM + ai * HALF + wr * 64 + m * 16 + fr;
#pragma unroll
                for (int bj = 0; bj < 2; ++bj) {
                    const size_t off = (size_t)row * 1024 + u.pn * BM + bj * HALF + wc * 32 + 8 * fq;
                    const f32x4 r0 = *(const f32x4*)(res + off), r1 = *(const f32x4*)(res + off + 4);
                    *(f32x4*)(y + off) = r0 * ALPHA + acc[ai][bj][m][0]; *(f32x4*)(y + off + 4) = r1 * ALPHA + acc[ai][bj][m][1];
                }
                asm volatile("" ::: "memory");
            }
    }
};
struct EpiBf16 {
    bf16_t* out; int ldc; float scale;
    __device__ __forceinline__ void operator()(const Acc& acc, const Unit& u, int wr, int wc, int fr, int fq) const {
#pragma unroll
        for (int ai = 0; ai < 2; ++ai)
#pragma unroll
            for (int m = 0; m < 4; ++m) {
                const int row = u.pm * BM + ai * HALF + wr * 64 + m * 16 + fr;
#pragma unroll
                for (int bj = 0; bj < 2; ++bj)
                    st8(out + (size_t)row * ldc + u.pn * BM + bj * HALF + wc * 32 + 8 * fq, acc[ai][bj][m][0] * scale, acc[ai][bj][m][1] * scale);
                asm volatile("" ::: "memory");
            }
    }
};
struct EpiSwiglu {
    bf16_t* out;
    __device__ __forceinline__ void operator()(const Acc& acc, const Unit& u, int wr, int wc, int fr, int fq) const {
#pragma unroll
        for (int ai = 0; ai < 2; ++ai)
#pragma unroll
            for (int m = 0; m < 4; ++m) {
                const int row = u.pm * BM + ai * HALF + wr * 64 + m * 16 + fr;
                f32x4 h0, h1;
#pragma unroll
                for (int j = 0; j < 4; ++j) { const float g0 = acc[ai][0][m][0][j], g1 = acc[ai][0][m][1][j];
                    h0[j] = g0 * sigmoidf_(g0) * acc[ai][1][m][0][j]; h1[j] = g1 * sigmoidf_(g1) * acc[ai][1][m][1][j]; }
                st8(out + (size_t)row * DFF + u.pn * HALF + wc * 32 + 8 * fq, h0, h1);
            }
    }
};
struct EpiSoftmax {
    bf16_t* P; LAS float* xl;
    __device__ __forceinline__ void operator()(Acc& acc, const Unit& u, int wr, int wc, int fr, int fq) const {
        constexpr float L2E = 1.4426950408889634f;
        LAS float* xw = xl + ((wr * 64 + fr) * 4 + wc) * 2; const LAS float* xr_ = xl + (wr * 64 + fr) * 8;
#pragma unroll
        for (int ai = 0; ai < 2; ++ai)
#pragma unroll
            for (int m = 0; m < 4; ++m) {
                float mx = -3.0e38f;
#pragma unroll
                for (int bj = 0; bj < 2; ++bj)
#pragma unroll
                    for (int n = 0; n < 2; ++n)
#pragma unroll
                        for (int j = 0; j < 4; ++j) mx = fmaxf(mx, acc[ai][bj][m][n][j]);
                mx = fmaxf(mx, __shfl_xor(mx, 16)); mx = fmaxf(mx, __shfl_xor(mx, 32));
                float s = 0.f;
#pragma unroll
                for (int bj = 0; bj < 2; ++bj)
#pragma unroll
                    for (int n = 0; n < 2; ++n)
#pragma unroll
                        for (int j = 0; j < 4; ++j) { const float e = __builtin_amdgcn_exp2f((acc[ai][bj][m][n][j] - mx) * L2E); acc[ai][bj][m][n][j] = e; s += e; }
                s += __shfl_xor(s, 16); s += __shfl_xor(s, 32);
                if (fq == 0) { xw[(ai * HALF + m * 16) * 8] = mx; xw[(ai * HALF + m * 16) * 8 + 1] = s; }
                asm volatile("" ::: "memory");
            }
        asm volatile("s_waitcnt lgkmcnt(0)" ::: "memory"); __builtin_amdgcn_s_barrier(); asm volatile("" ::: "memory");
#pragma unroll
        for (int ai = 0; ai < 2; ++ai)
#pragma unroll
            for (int m = 0; m < 4; ++m) {
                const int r = ai * HALF + wr * 64 + m * 16 + fr; const int row = u.pm * BM + r;
                const f32x4 a = *(const LAS f32x4*)(xr_ + (ai * HALF + m * 16) * 8), b = *(const LAS f32x4*)(xr_ + (ai * HALF + m * 16) * 8 + 4);
                const float M = fmaxf(fmaxf(a[0], a[2]), fmaxf(b[0], b[2]));
                const float tot = a[1] * __builtin_amdgcn_exp2f((a[0] - M) * L2E) + a[3] * __builtin_amdgcn_exp2f((a[2] - M) * L2E) + b[1] * __builtin_amdgcn_exp2f((b[0] - M) * L2E) + b[3] * __builtin_amdgcn_exp2f((b[2] - M) * L2E);
                const float mown = wc == 0 ? a[0] : wc == 1 ? a[2] : wc == 2 ? b[0] : b[2];
                const float f = __builtin_amdgcn_exp2f((mown - M) * L2E) * __builtin_amdgcn_rcpf(tot);
#pragma unroll
                for (int bj = 0; bj < 2; ++bj)
                    st8(P + (size_t)row * 1024 + u.pn * BM + bj * HALF + wc * 32 + 8 * fq, acc[ai][bj][m][0] * f, acc[ai][bj][m][1] * f);
                asm volatile("" ::: "memory");
            }
        asm volatile("s_waitcnt lgkmcnt(0)" ::: "memory"); __builtin_amdgcn_s_barrier(); asm volatile("" ::: "memory");
    }
};

struct LnStats { unsigned long long* xbuf; unsigned* cnt; };
template <bool WB> struct EpiResidLN {
    const float* res; float* yf; bf16_t* yb; const float* g; const float* b; LnStats st; LAS unsigned char* xl;
    __device__ __forceinline__ void operator()(Acc& acc, const Unit& u, int wr, int wc, int fr, int fq) const {
        const int wid = wr * 4 + wc, lane = fq * 16 + fr;
        LAS f32x2* P = (LAS f32x2*)xl; LAS f32x2* S = (LAS f32x2*)(xl + 8192); LAS unsigned* flag = (LAS unsigned*)(xl + 8192 + 2048);
#pragma unroll
        for (int ai = 0; ai < 2; ++ai) {
            f32x4 rv[4][2][2];
#pragma unroll
            for (int m = 0; m < 4; ++m) {
                const int row = u.pm * BM + ai * HALF + wr * 64 + m * 16 + fr;
#pragma unroll
                for (int bj = 0; bj < 2; ++bj) {
                    const size_t off = (size_t)row * 1024 + u.pn * BM + bj * HALF + wc * 32 + 8 * fq;
                    rv[m][bj][0] = *(const f32x4*)(res + off); rv[m][bj][1] = *(const f32x4*)(res + off + 4);
                }
            }
#pragma unroll
            for (int m = 0; m < 4; ++m) {
#pragma unroll
                for (int bj = 0; bj < 2; ++bj) { acc[ai][bj][m][0] = rv[m][bj][0] * ALPHA + acc[ai][bj][m][0]; acc[ai][bj][m][1] = rv[m][bj][1] * ALPHA + acc[ai][bj][m][1]; }
                asm volatile("" : "+v"(acc[ai][0][m][0]), "+v"(acc[ai][0][m][1]), "+v"(acc[ai][1][m][0]), "+v"(acc[ai][1][m][1]));
            }
            asm volatile("" ::: "memory");
        }
        f32x4 gv[2][2], bv[2][2];
#pragma unroll
        for (int bj = 0; bj < 2; ++bj)
#pragma unroll
            for (int n = 0; n < 2; ++n) { const int col = u.pn * BM + bj * HALF + wc * 32 + 8 * fq + 4 * n; gv[bj][n] = *(const f32x4*)(g + col); bv[bj][n] = *(const f32x4*)(b + col); }
#pragma unroll
        for (int ai = 0; ai < 2; ++ai)
#pragma unroll
            for (int m = 0; m < 4; ++m) {
                float s = 0.f;
#pragma unroll
                for (int bj = 0; bj < 2; ++bj)
#pragma unroll
                    for (int n = 0; n < 2; ++n) { const f32x4 x = acc[ai][bj][m][n]; s += (x[0] + x[1]) + (x[2] + x[3]); }
                s += __shfl_xor(s, 16); s += __shfl_xor(s, 32);
                const float mw = s * (1.0f / 64.0f); float q = 0.f;
#pragma unroll
                for (int bj = 0; bj < 2; ++bj)
#pragma unroll
                    for (int n = 0; n < 2; ++n) { const f32x4 d = acc[ai][bj][m][n] - mw; q += (d[0] * d[0] + d[1] * d[1]) + (d[2] * d[2] + d[3] * d[3]); }
                q += __shfl_xor(q, 16); q += __shfl_xor(q, 32);
                if (fq == 0) P[(ai * HALF + wr * 64 + m * 16 + fr) * 4 + wc] = (f32x2){mw, q};
            }
        asm volatile("s_waitcnt lgkmcnt(0)" ::: "memory"); __builtin_amdgcn_s_barrier(); asm volatile("" ::: "memory");
        const int row = wid * 32 + (lane & 31);
        unsigned* cw = st.cnt + 16 * u.pm;
        if (lane < 32) {
            const f32x2 a = P[row * 4 + 0], b2 = P[row * 4 + 1], c = P[row * 4 + 2], d = P[row * 4 + 3];
            const float mt = (a.x + b2.x + c.x + d.x) * 0.25f;
            const float da = a.x - mt, db = b2.x - mt, dc = c.x - mt, dd = d.x - mt;
            const float m2 = (a.y + b2.y) + (c.y + d.y) + 64.0f * ((da * da + db * db) + (dc * dc + dd * dd));
            unsigned long long* slot = st.xbuf + ((size_t)(u.pm * BM + row) * 4 + u.pn);
            __hip_atomic_store(slot, ((unsigned long long)__float_as_uint(m2) << 32) | __float_as_uint(mt), __ATOMIC_RELAXED, __HIP_MEMORY_SCOPE_AGENT);
        }
        asm volatile("s_waitcnt vmcnt(0)" ::: "memory");
        if (lane == 0) __hip_atomic_fetch_add(cw, 1u, __ATOMIC_RELAXED, __HIP_MEMORY_SCOPE_AGENT);
        if (wid == 0) {
            unsigned sp = 0;
            while ((unsigned)__builtin_amdgcn_readfirstlane(__hip_atomic_load(cw, __ATOMIC_RELAXED, __HIP_MEMORY_SCOPE_AGENT)) < 32u) { __builtin_amdgcn_s_sleep(2); if (++sp > (1u << 22)) break; }
            __builtin_amdgcn_fence(__ATOMIC_ACQUIRE, "agent");
            if (lane == 0) flag[0] = 0u;
        }
        asm volatile("s_waitcnt vmcnt(0) lgkmcnt(0)" ::: "memory"); __builtin_amdgcn_s_barrier(); asm volatile("" ::: "memory");
        if (lane < 32) {
            const unsigned long long* slot = st.xbuf + (size_t)(u.pm * BM + row) * 4; float mt[4], m2[4]; float ms = 0.f;
#pragma unroll
            for (int t = 0; t < 4; ++t) { const unsigned long long w = __hip_atomic_load(slot + t, __ATOMIC_RELAXED, __HIP_MEMORY_SCOPE_AGENT); mt[t] = __uint_as_float((unsigned)w); m2[t] = __uint_as_float((unsigned)(w >> 32)); ms += mt[t]; }
            const float mean = ms * 0.25f; float q = 0.f;
#pragma unroll
            for (int t = 0; t < 4; ++t) { const float dm = mt[t] - mean; q += m2[t] + 256.0f * dm * dm; }
            S[row] = (f32x2){mean, rsqrtf(q * (1.f / 1024.f) + LN_EPS)};
        }
        asm volatile("s_waitcnt lgkmcnt(0)" ::: "memory"); __builtin_amdgcn_s_barrier(); asm volatile("" ::: "memory");
#pragma unroll
        for (int ai = 0; ai < 2; ++ai)
#pragma unroll
            for (int m = 0; m < 4; ++m) {
                const int r = ai * HALF + wr * 64 + m * 16 + fr; const f32x2 sr = S[r];
#pragma unroll
                for (int bj = 0; bj < 2; ++bj) {
                    const size_t off = (size_t)(u.pm * BM + r) * 1024 + u.pn * BM + bj * HALF + wc * 32 + 8 * fq;
                    const f32x4 o0 = (acc[ai][bj][m][0] - sr.x) * sr.y * gv[bj][0] + bv[bj][0], o1 = (acc[ai][bj][m][1] - sr.x) * sr.y * gv[bj][1] + bv[bj][1];
                    *(f32x4*)(yf + off) = o0; *(f32x4*)(yf + off + 4) = o1;
                    if (WB) st8(yb + off, o0, o1);
                }
                asm volatile("" ::: "memory");
            }
        asm volatile("s_waitcnt lgkmcnt(0)" ::: "memory"); __builtin_amdgcn_s_barrier(); asm volatile("" ::: "memory");
    }
};
}

namespace dattn {
constexpr int KVBLK = 64, LDK = 1024;
constexpr size_t SHM_V = KVBLK * 128 * 2, SHM_K = KVBLK * 128 * 2;
constexpr int WS_OFF = 2 * SHM_V + 2 * SHM_K, EXCH_OFF = WS_OFF + NWAVES * 64 * 4;
constexpr float THR = 8.f;
#define KSWZ(row, colB) ((row) * 256 + ((colB) ^ (((row) & 7) << 4)))
#define SBAR() __builtin_amdgcn_sched_barrier(0)
__device__ __forceinline__ int crow(int r, int hi) { return (r & 3) + 8 * (r >> 2) + 4 * hi; }
constexpr float THR2 = THR * 1.4426950408889634f;
template <bool FIRST> __device__ __forceinline__ void partialSM(f32x16& p0, f32x16& p1, float& m_reg, f32x16& negm, float& alpha) {
  float pmax = p0[0];
#pragma unroll
  for (int r = 1; r < 16; ++r) pmax = fmaxf(pmax, p0[r]);
#pragma unroll
  for (int r = 0; r < 16; ++r) pmax = fmaxf(pmax, p1[r]);
  { auto rr = __builtin_amdgcn_permlane32_swap(__float_as_uint(pmax), __float_as_uint(pmax), false, false);
    pmax = fmaxf(__uint_as_float(rr[0]), __uint_as_float(rr[1])); }
  if (!FIRST && __builtin_expect(__all(pmax <= THR2), 1)) { alpha = 1.f; }
  else { const float d = FIRST ? pmax : fmaxf(pmax, 0.f); m_reg += d; alpha = FIRST ? 1.f : __builtin_amdgcn_exp2f(-d);
#pragma unroll
    for (int r = 0; r < 16; ++r) { p0[r] -= d; p1[r] -= d; }
#pragma unroll
    for (int r = 0; r < 16; ++r) negm[r] = -m_reg;
    asm volatile("" : "+v"(negm)); }
#pragma unroll
  for (int r = 0; r < 16; ++r) p0[r] = __builtin_amdgcn_exp2f(p0[r]);
}
__device__ __forceinline__ void finishSM(f32x16& p0, f32x16& p1, float alpha, float& l_reg, bf16x8& pa0, bf16x8& pa1, bf16x8& pa2, bf16x8& pa3, bool do_exp = true) {
  if (do_exp) {
#pragma unroll
  for (int r = 0; r < 16; ++r) p1[r] = __builtin_amdgcn_exp2f(p1[r]); }
  float ps = 0;
#pragma unroll
  for (int r = 0; r < 16; ++r) ps += p0[r];
#pragma unroll
  for (int r = 0; r < 16; ++r) ps += p1[r];
  { auto rr = __builtin_amdgcn_permlane32_swap(__float_as_uint(ps), __float_as_uint(ps), false, false);
    ps = __uint_as_float(rr[0]) + __uint_as_float(rr[1]); }
  l_reg = l_reg * alpha + ps;
#define PK4(P, BASE, OUT) do { unsigned a0 = cvt_pk_bf16(P[BASE + 0], P[BASE + 1]), a1 = cvt_pk_bf16(P[BASE + 2], P[BASE + 3]);   \
    unsigned b0 = cvt_pk_bf16(P[BASE + 4], P[BASE + 5]), b1 = cvt_pk_bf16(P[BASE + 6], P[BASE + 7]);                              \
    auto r0 = __builtin_amdgcn_permlane32_swap(a0, b0, false, false); auto r1 = __builtin_amdgcn_permlane32_swap(a1, b1, false, false); \
    u32x4 w = {r0[0], r1[0], r0[1], r1[1]}; OUT = *reinterpret_cast<bf16x8*>(&w); } while (0)
  PK4(p0, 0, pa0); PK4(p0, 8, pa1); PK4(p1, 0, pa2); PK4(p1, 8, pa3);
#undef PK4
}
template <bool FIRST> __device__ __forceinline__ void rowmaxSM(f32x16& p0, f32x16& p1, float& m_reg, f32x16& negm, float& alpha) {
  float pmax = p0[0];
#pragma unroll
  for (int r = 1; r < 16; ++r) pmax = fmaxf(pmax, p0[r]);
#pragma unroll
  for (int r = 0; r < 16; ++r) pmax = fmaxf(pmax, p1[r]);
  { auto rr = __builtin_amdgcn_permlane32_swap(__float_as_uint(pmax), __float_as_uint(pmax), false, false);
    pmax = fmaxf(__uint_as_float(rr[0]), __uint_as_float(rr[1])); }
  if (!FIRST && __builtin_expect(__all(pmax <= THR2), 1)) { alpha = 1.f; }
  else { const float d = FIRST ? pmax : fmaxf(pmax, 0.f); m_reg += d; alpha = FIRST ? 1.f : __builtin_amdgcn_exp2f(-d);
#pragma unroll
    for (int r = 0; r < 16; ++r) { p0[r] -= d; p1[r] -= d; }
#pragma unroll
    for (int r = 0; r < 16; ++r) negm[r] = -m_reg;
    asm volatile("" : "+v"(negm)); }
}
typedef short v4i16_t __attribute__((ext_vector_type(4)));
__device__ __forceinline__ s16x4 vtr(const LAS char* p) { return __builtin_bit_cast(s16x4, __builtin_amdgcn_ds_read_tr16_b64_v4i16((LAS v4i16_t*)p)); }
#define MF32(a, b, c) __builtin_amdgcn_mfma_f32_32x32x16_bf16(a, b, c, 0, 0, 0)
__device__ __forceinline__ void seg1(f32x16& C0, f32x16& C1, const f32x16& P0, const f32x16& P1, float alP, bf16x8& pa0, bf16x8& pa1, bf16x8& pa2, bf16x8& pa3,
                                     const LAS char* Ks, const bf16x8* qr, const f32x16& negm, int r32, int hi, int cofs) {
  unsigned rr[4][2][2];
#define KLD(d0, half) (*reinterpret_cast<const LAS bf16x8*>(Ks + KSWZ((half) * 32 + r32, ((cofs + (d0) * 16 + hi * 8) * 2))))
  bf16x8 kf[4][2];
#pragma unroll
  for (int d0 = 0; d0 < 4; ++d0) { kf[d0][0] = KLD(d0, 0); kf[d0][1] = KLD(d0, 1); }
  SBAR();
#pragma unroll
  for (int d0 = 0; d0 < 4; ++d0) {
    const bf16x8 ka = kf[d0][0], kb = kf[d0][1];
#pragma unroll
    for (int h2 = 0; h2 < 2; ++h2) { const int i = 2 * d0 + h2;
      if (h2 == 0) C0 = MF32(ka, qr[d0], d0 == 0 ? negm : C0); else C1 = MF32(kb, qr[d0], d0 == 0 ? negm : C1);
      { const int g = i >> 1, hf = i & 1, base = (g & 1) * 8 + hf * 2;
        const unsigned a_ = g < 2 ? cvt_pk_bf16(P0[base], P0[base + 1]) : cvt_pk_bf16(P1[base], P1[base + 1]);
        const unsigned b_ = g < 2 ? cvt_pk_bf16(P0[base + 4], P0[base + 5]) : cvt_pk_bf16(P1[base + 4], P1[base + 5]);
        auto r_ = __builtin_amdgcn_permlane32_swap(a_, b_, false, false); rr[g][hf][0] = r_[0]; rr[g][hf][1] = r_[1]; }
      SBAR();
    }
  }
#undef KLD
  { u32x4 w = {rr[0][0][0], rr[0][1][0], rr[0][0][1], rr[0][1][1]}; pa0 = *reinterpret_cast<bf16x8*>(&w); }
  { u32x4 w = {rr[1][0][0], rr[1][1][0], rr[1][0][1], rr[1][1][1]}; pa1 = *reinterpret_cast<bf16x8*>(&w); }
  { u32x4 w = {rr[2][0][0], rr[2][1][0], rr[2][0][1], rr[2][1][1]}; pa2 = *reinterpret_cast<bf16x8*>(&w); }
  { u32x4 w = {rr[3][0][0], rr[3][1][0], rr[3][0][1], rr[3][1][1]}; pa3 = *reinterpret_cast<bf16x8*>(&w); }
}
template <bool EXPS> __device__ __forceinline__ void seg2(f32x16* o, f32x16& ol, const LAS char* vp, bf16x8 pa0, bf16x8 pa1, bf16x8 pa2, bf16x8 pa3, f32x16& C0, f32x16& C1) {
#define VOFF(n, half) ((((n) >> 2) * 512) + (((n) & 3) * 4096) + (half) * 2048)
  constexpr int DEPTH = 4;
  s16x4 lo[DEPTH], hi_[DEPTH];
#pragma unroll
  for (int n = 0; n < DEPTH; ++n) { lo[n] = vtr(vp + VOFF(n, 0)); hi_[n] = vtr(vp + VOFF(n, 1)); }
  SBAR();
#pragma unroll
  for (int n = 0; n < 16; ++n) {
    const int sl = n % DEPTH;
    const bf16x8 vf = (bf16x8){lo[sl][0], lo[sl][1], lo[sl][2], lo[sl][3], hi_[sl][0], hi_[sl][1], hi_[sl][2], hi_[sl][3]};
    const int ks = n & 3, d0 = n >> 2;
    o[d0] = MF32(ks == 0 ? pa0 : ks == 1 ? pa1 : ks == 2 ? pa2 : pa3, vf, o[d0]);
    if (n + DEPTH < 16) { lo[sl] = vtr(vp + VOFF(n + DEPTH, 0)); hi_[sl] = vtr(vp + VOFF(n + DEPTH, 1)); }
    if (EXPS) {
      if (n < 8) { C0[2 * n] = __builtin_amdgcn_exp2f(C0[2 * n]); C0[2 * n + 1] = __builtin_amdgcn_exp2f(C0[2 * n + 1]); asm volatile("" : "+v"(C0)); }
      else { C1[2 * n - 16] = __builtin_amdgcn_exp2f(C1[2 * n - 16]); C1[2 * n - 15] = __builtin_amdgcn_exp2f(C1[2 * n - 15]); asm volatile("" : "+v"(C1)); }
    }
    SBAR();
  }
  { const bf16x8 ones = {0x3F80, 0x3F80, 0x3F80, 0x3F80, 0x3F80, 0x3F80, 0x3F80, 0x3F80};
    ol = MF32(pa0, ones, ol); ol = MF32(pa1, ones, ol); ol = MF32(pa2, ones, ol); ol = MF32(pa3, ones, ol); }
#undef VOFF
}
__device__ __forceinline__ void qkt(f32x16& p0, f32x16& p1, const char* Ks, const bf16x8* qr, int r32, int hi, int cofs, const f32x16& negm) {
#pragma unroll
  for (int d0 = 0; d0 < 4; ++d0) { int cb = (cofs + d0 * 16 + hi * 8) * 2;
    bf16x8 b0 = *reinterpret_cast<const bf16x8*>(Ks + KSWZ(r32, cb));
    bf16x8 b1 = *reinterpret_cast<const bf16x8*>(Ks + KSWZ(32 + r32, cb));
    if (d0 == 0) { p0 = __builtin_amdgcn_mfma_f32_32x32x16_bf16(b0, qr[0], negm, 0, 0, 0); p1 = __builtin_amdgcn_mfma_f32_32x32x16_bf16(b1, qr[0], negm, 0, 0, 0); }
    else { p0 = __builtin_amdgcn_mfma_f32_32x32x16_bf16(b0, qr[d0], p0, 0, 0, 0); p1 = __builtin_amdgcn_mfma_f32_32x32x16_bf16(b1, qr[d0], p1, 0, 0, 0); } }
}
__device__ __forceinline__ int v_st(int k, int c) { const int kk = (k & ~0xC) | ((k & 4) << 1) | ((k & 8) >> 1); return ((kk >> 3) * 4 + (c >> 5)) * 512 + ((kk & 7) * 32 + (c & 31)) * 2; }
__device__ __forceinline__ int v_rd_base(int lane) { return ((lane & 3) << 3) | (((lane >> 2) & 3) << 6) | (((lane >> 4) & 1) << 5) | (((lane >> 5) & 1) << 8); }
constexpr int v_rd_off(int d0, int ks, int half) { return d0 * 512 + ks * 4096 + half * 2048; }
template <int OFF> __device__ __forceinline__ s16x4 tr_read(int vb) {
  s16x4 r; asm volatile("ds_read_b64_tr_b16 %0, %1 offset:%2" : "=&v"(r) : "v"(vb), "i"(OFF) : "memory"); return r;
}
template <int D0> __device__ __forceinline__ void pv_one(f32x16& od, int vb, bf16x8 pa0, bf16x8 pa1, bf16x8 pa2, bf16x8 pa3) {
  const s16x4 l0 = tr_read<v_rd_off(D0, 0, 0)>(vb), h0 = tr_read<v_rd_off(D0, 0, 1)>(vb), l1 = tr_read<v_rd_off(D0, 1, 0)>(vb), h1 = tr_read<v_rd_off(D0, 1, 1)>(vb);
  const s16x4 l2 = tr_read<v_rd_off(D0, 2, 0)>(vb), h2 = tr_read<v_rd_off(D0, 2, 1)>(vb), l3 = tr_read<v_rd_off(D0, 3, 0)>(vb), h3 = tr_read<v_rd_off(D0, 3, 1)>(vb);
  asm volatile("s_waitcnt lgkmcnt(0)" ::: "memory"); SBAR();
#define PK(L, H) (bf16x8){L[0], L[1], L[2], L[3], H[0], H[1], H[2], H[3]}
  od = __builtin_amdgcn_mfma_f32_32x32x16_bf16(pa0, PK(l0, h0), od, 0, 0, 0);
  od = __builtin_amdgcn_mfma_f32_32x32x16_bf16(pa1, PK(l1, h1), od, 0, 0, 0);
  od = __builtin_amdgcn_mfma_f32_32x32x16_bf16(pa2, PK(l2, h2), od, 0, 0, 0);
  od = __builtin_amdgcn_mfma_f32_32x32x16_bf16(pa3, PK(l3, h3), od, 0, 0, 0);
#undef PK
}
__device__ __forceinline__ void pv_d0(f32x16* o, int vb, bf16x8 pa0, bf16x8 pa1, bf16x8 pa2, bf16x8 pa3) {
  pv_one<0>(o[0], vb, pa0, pa1, pa2, pa3); pv_one<1>(o[1], vb, pa0, pa1, pa2, pa3); pv_one<2>(o[2], vb, pa0, pa1, pa2, pa3); pv_one<3>(o[3], vb, pa0, pa1, pa2, pa3);
}
__device__ __forceinline__ void unit(const bf16_t* __restrict__ Qb, const bf16_t* __restrict__ Kh, const bf16_t* __restrict__ Vh, bf16_t* __restrict__ Ob, int ldo, int seq,
                                     char* lds, float lam, const float* __restrict__ subg) {
  int tid = threadIdx.x; asm volatile("" : "+v"(tid));
  const int wid = __builtin_amdgcn_readfirstlane(tid >> 6), lane = tid & 63, r32 = lane & 31, hi = lane >> 5;
  const int comp = wid & 1, rg = wid >> 1, cofs = comp * 64;
  char* V_lds = lds; char* K_lds = lds + 2 * SHM_V;
  float* ws = (float*)(lds + WS_OFF) + wid * 64; float* li_l = ws; float* al_l = ws + 32;
  float m_reg = 0.f; f32x16 o[4] = {}; f32x16 ol = {}; bf16x8 qr[4];
  const bf16_t* Qw = Qb + (long)(rg * 32 + r32) * 1024 + cofs + hi * 8;
#pragma unroll
  for (int d0 = 0; d0 < 4; ++d0) qr[d0] = *reinterpret_cast<const bf16x8*>(Qw + d0 * 16);
  const int sr = tid >> 4, sc = (tid & 15) * 8, vst0 = v_st(sr, sc), vst1 = v_st(32 + sr, sc);
  const int vb0 = (int)(uintptr_t)V_lds + v_rd_base(lane);
  struct { bf16x8 vs0, vs1, ks0, ks1; } sr_[1];
#define LD8(p) (*reinterpret_cast<const bf16x8*>(p))
#define SLOAD(i, k0) do { sr_[i].vs0 = LD8(&Vh[(long)((k0) + sr) * LDK + sc]); sr_[i].vs1 = LD8(&Vh[(long)((k0) + 32 + sr) * LDK + sc]); \
    sr_[i].ks0 = LD8(&Kh[(long)((k0) + sr) * LDK + sc]); sr_[i].ks1 = LD8(&Kh[(long)((k0) + 32 + sr) * LDK + sc]); } while (0)
#define SWRITE(b, i) do { *(bf16x8*)(V_lds + (b) * SHM_V + vst0) = sr_[i].vs0;          \
    *(bf16x8*)(V_lds + (b) * SHM_V + vst1) = sr_[i].vs1; int kc = sc * 2;               \
    *(bf16x8*)(K_lds + (b) * SHM_K + KSWZ(sr, kc)) = sr_[i].ks0;                       \
    *(bf16x8*)(K_lds + (b) * SHM_K + KSWZ(32 + sr, kc)) = sr_[i].ks1; } while (0)
#define SWAIT() asm volatile("s_waitcnt vmcnt(4)" ::: "memory")
#define RESC(a) do { if (__any((a) < 1.f)) { if (hi == 0) al_l[r32] = (a); asm volatile("s_waitcnt lgkmcnt(0)" ::: "memory"); \
    _Pragma("unroll") for (int r = 0; r < 16; ++r) { const float f_ = al_l[crow(r, hi)]; ol[r] *= f_; _Pragma("unroll") for (int d = 0; d < 4; ++d) o[d][r] *= f_; } } } while (0)
  f32x16 pA0, pA1, pB0, pB1; float alA, alB; f32x16 negm = {}; asm volatile("" : "+v"(negm)); bf16x8 pa0, pa1, pa2, pa3; const int NT = seq / KVBLK;
  const LAS char* Kl = (const LAS char*)K_lds; const LAS char* Vl = (const LAS char*)V_lds + v_rd_base(lane);
  SLOAD(0, 0); asm volatile("s_waitcnt vmcnt(0)" ::: "memory"); SWRITE(0, 0); SLOAD(0, KVBLK); __syncthreads();
  qkt(pA0, pA1, K_lds, qr, r32, hi, cofs, negm); rowmaxSM<true>(pA0, pA1, m_reg, negm, alA);
#pragma unroll
  for (int r = 0; r < 16; ++r) { pA0[r] = __builtin_amdgcn_exp2f(pA0[r]); pA1[r] = __builtin_amdgcn_exp2f(pA1[r]); }
  asm volatile("s_waitcnt vmcnt(0)" ::: "memory"); SWRITE(1, 0); SLOAD(0, 2 * KVBLK); __syncthreads();
#pragma unroll 1
  for (int j = 1; j + 1 < NT; j += 2) {
    SBAR(); seg1(pB0, pB1, pA0, pA1, alA, pa0, pa1, pa2, pa3, Kl + SHM_K, qr, negm, r32, hi, cofs);
    rowmaxSM<false>(pB0, pB1, m_reg, negm, alB); SBAR();
    seg2<true>(o, ol, Vl, pa0, pa1, pa2, pa3, pB0, pB1);
    __syncthreads(); asm volatile("s_waitcnt vmcnt(0)" ::: "memory"); SWRITE(0, 0); SLOAD(0, (j + 2) * KVBLK);
    RESC(alB); __syncthreads();
    SBAR(); seg1(pA0, pA1, pB0, pB1, alB, pa0, pa1, pa2, pa3, Kl, qr, negm, r32, hi, cofs);
    rowmaxSM<false>(pA0, pA1, m_reg, negm, alA); SBAR();
    seg2<true>(o, ol, Vl + SHM_V, pa0, pa1, pa2, pa3, pA0, pA1);
    __syncthreads(); asm volatile("s_waitcnt vmcnt(0)" ::: "memory"); SWRITE(1, 0); if (j + 3 < NT) SLOAD(0, (j + 3) * KVBLK);
    RESC(alA); __syncthreads();
  }
  SBAR(); seg1(pB0, pB1, pA0, pA1, alA, pa0, pa1, pa2, pa3, Kl + SHM_K, qr, negm, r32, hi, cofs); SBAR();
  rowmaxSM<false>(pB0, pB1, m_reg, negm, alB); SBAR();
  seg2<true>(o, ol, Vl, pa0, pa1, pa2, pa3, pB0, pB1);
  __syncthreads(); RESC(alB);
  { float dl = 0.f; finishSM(pB0, pB1, alB, dl, pa0, pa1, pa2, pa3, false); } SBAR();
  seg2<false>(o, ol, Vl + SHM_V, pa0, pa1, pa2, pa3, pB0, pB1);
  float rli[16];
#pragma unroll
  for (int r = 0; r < 16; ++r) rli[r] = __builtin_amdgcn_rcpf(ol[r]);
  float* ex = (float*)(lds + EXCH_OFF) + rg * 4096;
  if (comp == 1) {
#pragma unroll
    for (int d0 = 0; d0 < 4; ++d0)
#pragma unroll
      for (int r = 0; r < 16; ++r) ex[(d0 * 16 + r) * 64 + lane] = o[d0][r] * rli[r] * lam;
  }
  __syncthreads();
  if (comp == 0) {
    float gv[4];
#pragma unroll
    for (int d0 = 0; d0 < 4; ++d0) gv[d0] = subg[d0 * 32 + r32] * (1.f - LAMBDA_INIT);
#pragma unroll
    for (int r = 0; r < 16; ++r)
#pragma unroll
      for (int d0 = 0; d0 < 4; ++d0) o[d0][r] = o[d0][r] * rli[r] - ex[(d0 * 16 + r) * 64 + lane];
    asm volatile("s_waitcnt lgkmcnt(0)" ::: "memory");
    char* stg = (char*)ex;
#pragma unroll
    for (int r = 0; r < 16; ++r) {
      float ss = 0.f;
#pragma unroll
      for (int d0 = 0; d0 < 4; ++d0) ss += o[d0][r] * o[d0][r];
#pragma unroll
      for (int s = 1; s < 32; s <<= 1) ss += __shfl_xor(ss, s);
      const float rs = rsqrtf(ss * (1.f / 128.f) + SUBLN_EPS);
      bf16_t* srow = (bf16_t*)(stg + crow(r, hi) * 272) + r32;
#pragma unroll
      for (int d0 = 0; d0 < 4; ++d0) srow[d0 * 32] = (bf16_t)(cvt_pk_bf16(o[d0][r] * rs * gv[d0], 0.f) & 0xffffu);
    }
    asm volatile("s_waitcnt lgkmcnt(0)" ::: "memory");
#pragma unroll
    for (int i = 0; i < 8; ++i) { const int row = i * 4 + (lane >> 4), ch = lane & 15;
      const u32x4 v = *(const u32x4*)(stg + row * 272 + ch * 16);
      *(u32x4*)(Ob + (long)(rg * 32 + row) * ldo + ch * 8) = v; }
  }
  __syncthreads();
#undef LD8
#undef SLOAD
#undef SWRITE
#undef SWAIT
#undef RESC
}
#undef SBAR
}

namespace lru {
constexpr int CH = 64, AST = 272;
constexpr int L_A = 0, L_XCF = 17408, L_G = L_XCF + 32768, L_PS = L_G + 65536;
struct Params { const bf16_t* xr; bf16_t* hf; const bf16_t* gyr; bf16_t* lo; const bf16_t* Wt; const float* conv_w; const float* conv_b; const float* ba; const float* bx; const float* aparam; };
__device__ __forceinline__ void unit(const Params& P, int uid, int Tseq, char* lds) {
  int tid = threadIdx.x; asm volatile("" : "+v"(tid));
  const int wid = __builtin_amdgcn_readfirstlane(tid >> 6), lane = tid & 63, r32 = lane & 31, hi = lane >> 5;
  const int nb = uid & 7, sq = uid >> 3;
  const long rowbase = (long)sq * Tseq; const int cb0 = nb * 128;
  const int cg8 = tid & 15, tgp = tid >> 4; const int cch = cb0 + cg8 * 8;
  const int gate = wid & 1, cgp = wid >> 1;
  const int c = tid & 127, sg = tid >> 7;
  const int nch = Tseq / CH;
  const bf16_t* xcol = P.xr + (size_t)rowbase * 1024 + cch;
  bf16_t* hfcol = P.hf + (size_t)rowbase * 1024 + cb0 + c;
  const bf16_t* gcol = P.gyr + (size_t)rowbase * 1024 + cb0 + c;
  bf16_t* locol = P.lo + (size_t)rowbase * 2048 + 1024 + cb0 + c;
  float* xcf = (float*)(lds + L_XCF); float* G = (float*)(lds + L_G); f32x2* PS = (f32x2*)(lds + L_PS);
  float* cwl = (float*)(lds + L_PS + 4096);
  if (tid < 160) { const int j = tid >> 5, c4 = (tid & 31) * 4; const float* srcp = j < 4 ? P.conv_w + j * 1024 + cb0 + c4 : P.conv_b + cb0 + c4; *(f32x4*)(cwl + j * 128 + c4) = *(const f32x4*)srcp; }
  __syncthreads();
#pragma unroll 1
  for (int dir = 0; dir < 2; ++dir) {
    const float gbias = (gate == 0 ? P.ba : P.bx)[dir * 1024 + cb0 + cgp * 32 + r32];
    float sp; { const float z = -P.aparam[dir * 1024 + cb0 + c]; sp = fmaxf(z, 0.f) + log1pf(__expf(-fabsf(z))); }
    const float spl = -8.f * 1.4426950408889634f * sp;
    float carry = 0.f;
    bf16x8 xin[5];
#define LRU_LOAD(cc) do { const int tb = (cc) * CH + 2 * tgp - 2; _Pragma("unroll") for (int i = 0; i < 5; ++i) { const int t = tb + i; \
      xin[i] = (t >= 0 && t < Tseq) ? *(const bf16x8*)(xcol + (size_t)t * 1024) : (bf16x8){0, 0, 0, 0, 0, 0, 0, 0}; } } while (0)
    LRU_LOAD(dir ? nch - 1 : 0);
#pragma unroll 1
    for (int ci = 0; ci < nch; ++ci) {
      const int cc = dir ? nch - 1 - ci : ci, t0 = cc * CH;
      bf16x8 bfr[8];
      { const bf16_t* wt = P.Wt; asm volatile("" : "+s"(wt));
        const GAS bf16_t* wp = (const GAS bf16_t*)(wt + ((size_t)((dir * 2 + gate) * 8 + nb)) * 16384 + (size_t)(cgp * 32 + r32) * 128 + hi * 8);
#pragma unroll
        for (int ks = 0; ks < 8; ++ks) bfr[ks] = *(const GAS bf16x8*)(wp + ks * 16); }
      { float cw[4][8], cbias[8];
        {
#pragma unroll
          for (int j = 0; j < 4; ++j) { const f32x4 a = *(const f32x4*)(cwl + j * 128 + cg8 * 8), b = *(const f32x4*)(cwl + j * 128 + cg8 * 8 + 4);
#pragma unroll
            for (int e = 0; e < 4; ++e) { cw[j][e] = a[e]; cw[j][4 + e] = b[e]; } }
          const f32x4 a = *(const f32x4*)(cwl + 512 + cg8 * 8), b = *(const f32x4*)(cwl + 512 + cg8 * 8 + 4);
#pragma unroll
          for (int e = 0; e < 4; ++e) { cbias[e] = a[e]; cbias[4 + e] = b[e]; } }
        float xf[5][8];
#pragma unroll
        for (int i = 0; i < 5; ++i)
#pragma unroll
          for (int e = 0; e < 8; ++e) xf[i][e] = bf2f((unsigned short)xin[i][e]);
#pragma unroll
        for (int i = 0; i < 2; ++i) {
          float xc[8];
#pragma unroll
          for (int e = 0; e < 8; ++e) xc[e] = cbias[e] + cw[0][e] * xf[i][e] + cw[1][e] * xf[i + 1][e] + cw[2][e] * xf[i + 2][e] + cw[3][e] * xf[i + 3][e];
          u32x4 w; w.x = cvt_pk_bf16(xc[0], xc[1]); w.y = cvt_pk_bf16(xc[2], xc[3]); w.z = cvt_pk_bf16(xc[4], xc[5]); w.w = cvt_pk_bf16(xc[6], xc[7]);
          *(u32x4*)(lds + L_A + (2 * tgp + i) * AST + cg8 * 16) = w;
          float* xp = xcf + (2 * tgp + i) * 128 + cg8 * 8; *(f32x4*)xp = (f32x4){xc[0], xc[1], xc[2], xc[3]}; *(f32x4*)(xp + 4) = (f32x4){xc[4], xc[5], xc[6], xc[7]};
        } }
      if (ci + 1 < nch) LRU_LOAD(dir ? nch - 2 - ci : ci + 1);
      __syncthreads();
#pragma unroll
      for (int tg = 0; tg < 2; ++tg) { f32x16 acc = {};
#pragma unroll
        for (int ks = 0; ks < 8; ++ks) { const bf16x8 a = *(const bf16x8*)(lds + L_A + (tg * 32 + r32) * AST + ks * 32 + hi * 16);
          acc = __builtin_amdgcn_mfma_f32_32x32x16_bf16(a, bfr[ks], acc, 0, 0, 0); }
#pragma unroll
        for (int r = 0; r < 16; ++r) { const int tok = tg * 32 + dattn::crow(r, hi); G[(gate * CH + tok) * 128 + cgp * 32 + r32] = sigmoidf_(acc[r] + gbias); } }
      __syncthreads();
      unsigned short hfv[16], gyv[16];
      if (dir) { const GAS bf16_t* hp = (const GAS bf16_t*)(hfcol + (size_t)(t0 + CH - 1 - sg * 16) * 1024); const GAS bf16_t* gp = (const GAS bf16_t*)(gcol + (size_t)(t0 + CH - 1 - sg * 16) * 1024);
#pragma unroll
        for (int k = 0; k < 16; ++k) { hfv[k] = *hp; gyv[k] = *gp; hp -= 1024; gp -= 1024; asm volatile("" : "+v"(hp), "+v"(gp)); } }
      float av[16], uv[16]; float Pp = 1.f, Ss = 0.f;
#pragma unroll
      for (int k = 0; k < 16; ++k) { const int p = sg * 16 + k, tl = dir ? CH - 1 - p : p;
        const float r_ = G[tl * 128 + c], i_ = G[(CH + tl) * 128 + c], x_ = xcf[tl * 128 + c];
        const float a = __builtin_amdgcn_exp2f(spl * r_); float mult = __builtin_amdgcn_sqrtf(fmaxf(1.f - a * a, 0.f));
        if (ci == 0 && p == 0) mult = 1.f;
        const float u = mult * i_ * x_; av[k] = a; uv[k] = u; Ss = a * Ss + u; Pp *= a; }
      PS[sg * 128 + c] = (f32x2){Pp, Ss};
      __syncthreads();
      float h = carry, hin = 0.f;
#pragma unroll
      for (int s2 = 0; s2 < 4; ++s2) { const f32x2 ps = PS[s2 * 128 + c]; if (s2 == sg) hin = h; h = ps[0] * h + ps[1]; }
      carry = h; h = hin;
      if (dir == 0) { GAS bf16_t* hp = (GAS bf16_t*)(hfcol + (size_t)(t0 + sg * 16) * 1024);
#pragma unroll
        for (int k = 0; k < 16; ++k) { h = av[k] * h + uv[k]; *hp = (bf16_t)(cvt_pk_bf16(h, 0.f) & 0xffffu); hp += 1024; asm volatile("" : "+v"(hp)); }
      } else { GAS bf16_t* lp = (GAS bf16_t*)(locol + (size_t)(t0 + CH - 1 - sg * 16) * 2048);
#pragma unroll
        for (int k = 0; k < 16; ++k) { h = av[k] * h + uv[k];
          *lp = (bf16_t)(cvt_pk_bf16((h + bf2f(hfv[k])) * bf2f(gyv[k]), 0.f) & 0xffffu); lp -= 2048; asm volatile("" : "+v"(lp)); }
      }
    }
    asm volatile("s_waitcnt vmcnt(0)" ::: "memory");
    __syncthreads();
#undef LRU_LOAD
  }
}
}

__device__ __forceinline__ unsigned pk2(float lo, float hi) { return cvt_pk_bf16(lo, hi); }
__device__ __forceinline__ void transpose_item(const float* W, int K, int N, bf16_t* WT, int k0, int n0, int drow0, LAS float* scr, int lane, int ldk = 0, int koff = 0) {
    if (ldk == 0) ldk = K;
#pragma unroll 8
    for (int i = 0; i < 32; ++i) { const int kk = 2 * i + (lane >> 5); scr[kk * 33 + (lane & 31)] = W[(size_t)(k0 + kk) * N + n0 + (lane & 31)]; }
    asm volatile("s_waitcnt lgkmcnt(0)" ::: "memory");
    const int c = lane & 7;
#pragma unroll
    for (int j = 0; j < 4; ++j) { const int n = (lane >> 3) + 8 * j; const LAS float* s = scr + (8 * c) * 33 + n;
        u32x4 o; o.x = pk2(s[0 * 33], s[1 * 33]); o.y = pk2(s[2 * 33], s[3 * 33]); o.z = pk2(s[4 * 33], s[5 * 33]); o.w = pk2(s[6 * 33], s[7 * 33]);
        *(u32x4*)(WT + (size_t)(drow0 + n) * ldk + koff + k0 + 8 * c) = o; }
    asm volatile("s_waitcnt lgkmcnt(0)" ::: "memory");
}
__device__ __forceinline__ int ffin_row(int n) { return n < DFF ? (n >> 7) * 256 + (n & 127) : ((n - DFF) >> 7) * 256 + 128 + ((n - DFF) & 127); }
__device__ __forceinline__ void cvt_rows(const float* src, bf16_t* dst, size_t n8, size_t gtid, size_t gthreads) {
    for (size_t i = gtid; i < n8; i += gthreads) { const f32x4 a = *(const f32x4*)(src + i * 8), b = *(const f32x4*)(src + i * 8 + 4);
        u32x4 w; w.x = pk2(a[0], a[1]); w.y = pk2(a[2], a[3]); w.z = pk2(b[0], b[1]); w.w = pk2(b[2], b[3]); *(u32x4*)(dst + i * 8) = w; }
}
__device__ __forceinline__ void ln_row(const float* yrow, const float* g, const float* b, float* of, bf16_t* ob, int lane) {
    f32x4 v[4]; float s = 0.f;
#pragma unroll
    for (int j = 0; j < 4; ++j) { v[j] = *(const f32x4*)(yrow + 256 * j + 4 * lane); s += (v[j][0] + v[j][1]) + (v[j][2] + v[j][3]); }
    const float mean = wave_sum(s) * (1.f / 1024.f); float s2 = 0.f;
#pragma unroll
    for (int j = 0; j < 4; ++j) { v[j] = v[j] - mean; s2 += (v[j][0] * v[j][0] + v[j][1] * v[j][1]) + (v[j][2] * v[j][2] + v[j][3] * v[j][3]); }
    const float rstd = rsqrtf(wave_sum(s2) * (1.f / 1024.f) + LN_EPS);
#pragma unroll
    for (int j = 0; j < 4; ++j) { const f32x4 gg = *(const f32x4*)(g + 256 * j + 4 * lane), bb = *(const f32x4*)(b + 256 * j + 4 * lane);
        const f32x4 o = v[j] * rstd * gg + bb; *(f32x4*)(of + 256 * j + 4 * lane) = o;
        if (ob) { u32x2 w; w.x = pk2(o[0], o[1]); w.y = pk2(o[2], o[3]); *(u32x2*)(ob + 256 * j + 4 * lane) = w; } }
}


#define XB_TMO      128
#define XB_XCNT(j)  (256  + 64 * (j))
#define XB_XSUB(j)  (1280 + 64 * (j))
#define XB_XGEN(j)  (2304 + 64 * (j))
#define XB_TOP      3328
#define XB_TOPGEN   3392
#define XCD_BAR_WORDS 3456
#define XB_SPIN_CAP (1u << 20)
__device__ __forceinline__ unsigned xb_ld(unsigned* p)              { return __hip_atomic_load(p, __ATOMIC_RELAXED, __HIP_MEMORY_SCOPE_AGENT); }
__device__ __forceinline__ unsigned xb_add(unsigned* p, unsigned v) { return __hip_atomic_fetch_add(p, v, __ATOMIC_RELAXED, __HIP_MEMORY_SCOPE_AGENT); }
__device__ __forceinline__ unsigned xb_xcc_id() { return (unsigned)__builtin_amdgcn_s_getreg((3 << 11) | 20) & 0xFu; }
#define XB_SPIN(cond, bar) do { unsigned _sp = 0; while (cond) { __builtin_amdgcn_s_sleep(1); \
    if ((++_sp & 255u) == 0u) { if (xb_ld(&(bar)[XB_TMO])) break; if (_sp > XB_SPIN_CAP) { atomicAdd(&(bar)[XB_TMO], 1u); break; } } } } while (0)
struct XcdBarrier { unsigned* bar; unsigned x; volatile LAS unsigned* st; };
__device__ __forceinline__ XcdBarrier xcd_barrier_post(unsigned* bar, volatile LAS unsigned* st) {
    XcdBarrier b; b.bar = bar; b.x = xb_xcc_id(); b.st = st;
    if (threadIdx.x == 0) (void)xb_add(&bar[XB_XCNT(b.x)], 1u);
    return b;
}
__device__ __forceinline__ void xcd_barrier_complete(unsigned* bar, unsigned x, unsigned& nloc, unsigned& nx) {
    const unsigned G = gridDim.x * gridDim.y * gridDim.z;
    unsigned sum, cnt, mine, sp = 0u;
    for (;;) {
        sum = 0u; cnt = 0u; mine = 0u;
#pragma unroll
        for (unsigned j = 0; j < 16; ++j) { const unsigned c = xb_ld(&bar[XB_XCNT(j)]); sum += c; cnt += (c > 0u) ? 1u : 0u; mine = (j == x) ? c : mine; }
        if (sum == G) break;
        __builtin_amdgcn_s_sleep(1);
        if ((++sp & 255u) == 0u) { if (xb_ld(&bar[XB_TMO])) break; if (sp > XB_SPIN_CAP) { atomicAdd(&bar[XB_TMO], 1u); break; } }
    }
    nloc = mine > 0u ? mine : 1u; nx = cnt > 0u ? cnt : 1u;
}
__device__ __forceinline__ void xcd_barrier(const XcdBarrier& b) {
    asm volatile("s_waitcnt vmcnt(0)" ::: "memory");
    __syncthreads();
    if (threadIdx.x == 0) {
        unsigned* bar = b.bar;
        __builtin_amdgcn_s_waitcnt(0);
        unsigned nloc = b.st[0], nx = b.st[1];
        if (nloc == 0u) { xcd_barrier_complete(bar, b.x, nloc, nx); b.st[0] = nloc; b.st[1] = nx; }
        const unsigned old = xb_add(&bar[XB_XSUB(b.x)], 1u);
        const unsigned gen = old / nloc;
        if (old + 1u == (gen + 1u) * nloc) {
            __builtin_amdgcn_fence(__ATOMIC_RELEASE, "agent");
            asm volatile("s_waitcnt vmcnt(0)" ::: "memory");
            const unsigned og = xb_add(&bar[XB_TOP], 1u);
            const unsigned tg = og / nx;
            if (og + 1u == (tg + 1u) * nx) xb_add(&bar[XB_TOPGEN], 1u);
            else XB_SPIN(xb_ld(&bar[XB_TOPGEN]) == tg, bar);
            __builtin_amdgcn_fence(__ATOMIC_ACQUIRE, "agent");
            xb_add(&bar[XB_XGEN(b.x)], 1u);
            asm volatile("s_waitcnt vmcnt(0)" ::: "memory");
        } else {
            XB_SPIN(xb_ld(&bar[XB_XGEN(b.x)]) == gen, bar);
            __builtin_amdgcn_fence(__ATOMIC_ACQUIRE, "agent");
            asm volatile("s_waitcnt vmcnt(0)" ::: "memory");
        }
    }
    __syncthreads();
}

constexpr size_t WS_PTRS = 8192;
__device__ __forceinline__ const float* inptr(const unsigned char* ws, int i) {
    const GAS unsigned* p = (const GAS unsigned*)(ws + WS_PTRS) + 2 * i;
    const unsigned lo = __builtin_amdgcn_readfirstlane(p[0]), hi = __builtin_amdgcn_readfirstlane(p[1]);
    return (const float*)(const GAS float*)(((unsigned long long)hi << 32) | lo);
}
#ifndef PH_MASK
#define PH_MASK 0xffffffffu
#endif
#define PHON(k) ((PH_MASK >> (k)) & 1u)
#ifndef REP_MASK
#define REP_MASK 0u
#endif
#define NREP(k) (1 + (int)((REP_MASK >> (k)) & 1u))
struct Args { const float* in[31]; float* out; unsigned char* ws; int ph_lo, ph_hi; };
enum { I_XP = 0, I_XS, I_MP, I_MS, I_WIN, I_LQ1, I_LK1, I_LQ2, I_LK2, I_SUBG, I_CONVW, I_CONVB, I_LWA, I_LBA, I_LWX, I_LBX, I_LA, I_PATTN, I_PLRU, I_WMIX,
       I_LN1G, I_LN1B, I_XAQ, I_XAKV, I_XAO, I_LN2G, I_LN2B, I_FFIN, I_FFOUT, I_LN3G, I_LN3B };

__global__ void __launch_bounds__(NTHREADS, 2) mk_fwd(Args args) {
    extern __shared__ __attribute__((aligned(16))) unsigned char lds_raw[];
    cg::grid_group grid = cg::this_grid();
    int phase = 0;
    volatile LAS unsigned* bst = (volatile LAS unsigned*)((LAS unsigned char*)lds_raw + LDS_BYTES - 128);
    if (threadIdx.x < 2) bst[threadIdx.x] = 0u;
    __syncthreads();
    const XcdBarrier xbar = xcd_barrier_post((unsigned*)(args.ws + WS_CTL) + CW_BAR, bst);
#define SEAM() do { ++phase; if (phase > args.ph_lo && phase < args.ph_hi) { if (args.ph_lo < 0) grid.sync(); else xcd_barrier(xbar); } } while (0)
#define ACTIVE() (phase >= args.ph_lo && phase < args.ph_hi)
#define FRESH() LAS unsigned char* lds = (LAS unsigned char*)lds_raw; int tid = threadIdx.x; asm volatile("" : "+v"(tid)); \
    const int lane = tid & 63, wave = __builtin_amdgcn_readfirstlane(tid >> 6); GAS unsigned char* wsg_ = (GAS unsigned char*)args.ws; asm volatile("" : "+s"(wsg_)); unsigned char* ws = (unsigned char*)wsg_; \
    const int G = gridDim.x, bx = blockIdx.x; const size_t gtid = (size_t)bx * NTHREADS + tid, gthreads = (size_t)G * NTHREADS; const int gw = bx * NWAVES + wave, NGW = G * NWAVES; \
    (void)lds; (void)lane; (void)wave; (void)gtid; (void)gthreads; (void)gw; (void)NGW;
#define WSP(T, off) ((T*)(ws + (off)))
#define INP(i) inptr(ws, (i))

    if (ACTIVE() && PHON(0)) {
        FRESH();
        unsigned* ctl = WSP(unsigned, WS_CTL); float* rope = WSP(float, WS_ROPE);
        if (bx == 0 && tid < 256) ctl[CW_QUEUE + tid] = 0u;
        if (gtid == 0) { const float** tbl = WSP(const float*, WS_PTRS);
#pragma unroll
            for (int i = 0; i < 31; ++i) tbl[i] = args.in[i]; }
        if (bx == 0 && wave == 1) {
            const float a = wave_sum(args.in[I_LQ1][lane] * args.in[I_LK1][lane]), b = wave_sum(args.in[I_LQ2][lane] * args.in[I_LK2][lane]);
            if (lane == 0) ((float*)ctl)[CW_LAM] = __expf(a) - __expf(b) + LAMBDA_INIT;
        }
        for (size_t i = gtid; i < 8192 * 8; i += gthreads) { const int t = (int)(i >> 3), j = (int)(i & 7);
            const float inv = exp2f(-(float)j * 0.125f * 18.931568569324174f);
            const float ang = (float)t * inv; const double rev = (double)ang * 0.15915494309189535; const float fr = (float)(rev - floor(rev));
            rope[t * 16 + j] = __builtin_amdgcn_cosf(fr); rope[t * 16 + 8 + j] = __builtin_amdgcn_sinf(fr); }
        LAS float* scr = (LAS float*)(lds + wave * 16384);
        int it0 = gw;
#pragma unroll 1
        for (int jb = 0; jb < 9; ++jb) {
            const float* W; int K = 1024, N = 1024; bf16_t* WT; int kind = 0, ldk = 0, koff = 0;
            switch (jb) {
                case 0: W = args.in[I_WIN]; N = INW; WT = WSP(bf16_t, WS_WIN); break;
                case 1: W = args.in[I_PATTN]; WT = WSP(bf16_t, WS_PATTN); ldk = 2048; break;
                case 2: W = args.in[I_PLRU]; WT = WSP(bf16_t, WS_PATTN); ldk = 2048; koff = 1024; break;
                case 3: W = args.in[I_WMIX]; WT = WSP(bf16_t, WS_WMIX); break;
                case 4: W = args.in[I_XAQ]; WT = WSP(bf16_t, WS_XAQ); break;
                case 5: W = args.in[I_XAO]; WT = WSP(bf16_t, WS_XAO); break;
                case 6: W = args.in[I_XAKV]; N = 2048; WT = WSP(bf16_t, WS_XAKV); break;
                case 7: W = args.in[I_FFIN]; N = 2 * DFF; WT = WSP(bf16_t, WS_FFIN); kind = 1; break;
                default: W = args.in[I_FFOUT]; K = DFF; WT = WSP(bf16_t, WS_FFOUT); break;
            }
            const int nblk = N / 32, nit = (K / 64) * nblk;
#pragma unroll 1
            for (; it0 < nit; it0 += NGW) { const int kb = it0 / nblk, nbk = it0 % nblk, n0 = 32 * nbk;
                transpose_item(W, K, N, WT, 64 * kb, n0, kind ? ffin_row(n0) : n0, scr, lane, ldk, koff); }
            it0 -= nit; }
#pragma unroll 1
        for (int it = gw; it < 32 * 8; it += NGW) { const int mat = it >> 3, sub = it & 7, kb = sub >> 2, nbk = sub & 3;
            const int dir = mat >> 4, gate = (mat >> 3) & 1, nb = mat & 7;
            const float* src = (gate == 0 ? args.in[I_LWA] : args.in[I_LWX]) + (size_t)(dir * 8 + nb) * 16384;
            transpose_item(src, 128, 128, WSP(bf16_t, WS_LRUW) + (size_t)mat * 16384, 64 * kb, 32 * nbk, 32 * nbk, scr, lane); }
        cvt_rows(args.in[I_XP], WSP(bf16_t, WS_XB), (size_t)RM * 1024 / 8, gtid, gthreads);
        cvt_rows(args.in[I_XS], WSP(bf16_t, WS_XB) + (size_t)RM * 1024, (size_t)2 * RM * 1024 / 8, gtid, gthreads);
        cvt_rows(args.in[I_MP], WSP(bf16_t, WS_MEMB), (size_t)1024 * 1024 / 8, gtid, gthreads);
        cvt_rows(args.in[I_MS], WSP(bf16_t, WS_MEMB) + (size_t)1024 * 1024, (size_t)8192 * 1024 / 8, gtid, gthreads);
    }
    SEAM();

#pragma unroll 1
    for (int r = 0; r < NROUND; ++r) {
        const int Tseq = r == 0 ? 8192 : 2048, nseq = RM / Tseq, seq0 = r == 0 ? 0 : 4 + (r - 1) * 16, tsh = r == 0 ? 5 : 3;
#define XIN() (r == 0 ? INP(I_XP) : INP(I_XS) + (size_t)(r - 1) * RM * 1024)
#define OUTR() (args.out + (size_t)r * RM * 1024)

        if (ACTIVE() && PHON(1)) {
            FRESH();
            for (int rep = 0; rep < NREP(1); ++rep)
            { pg8::Gemm g{WSP(bf16_t, WS_XB) + (size_t)r * RM * 1024, WSP(bf16_t, WS_WIN), 1024, 1024, 1024}; pg8::StaticOrder S; S.init(RM, INW, G, bx);
              pg8::EpiProj E{WSP(bf16_t, WS_Q), WSP(float, WS_ROPE), Tseq - 1}; pg8::gemm_phase(lds, g, S, E); }
            if (r == 0) { pg8::Gemm g{WSP(bf16_t, WS_MEMB), WSP(bf16_t, WS_XAKV), 1024, 1024, 1024}; pg8::StaticOrder S; S.init(NMEMROW, 2048, G, bx);
              pg8::EpiKV E{WSP(bf16_t, WS_KX), WSP(bf16_t, WS_VXT)}; pg8::gemm_phase(lds, g, S, E); }
        }
        SEAM();
        if (ACTIVE() && PHON(2)) {
            FRESH();
            unsigned* ctl = WSP(unsigned, WS_CTL);
            const int nlru = nseq * 8, qpb = Tseq / 128, natt = nseq * 8 * qpb;
            LAS int* qslot = (LAS int*)(lds + LDS_BYTES - 64);
            if (PHON(16)) {
                const lru::Params LP{WSP(bf16_t, WS_XR), (bf16_t*)OUTR(), WSP(bf16_t, WS_GYR), WSP(bf16_t, WS_AOLO), WSP(bf16_t, WS_LRUW), INP(I_CONVW), INP(I_CONVB), INP(I_LBA), INP(I_LBX), INP(I_LA)};
                for (int rep = 0; rep < NREP(16); ++rep) for (;;) {
                    if (tid == 0) *qslot = (int)atomicAdd(ctl + CW_QUEUE + 64 * r + 8 * rep, 1u);
                    __syncthreads();
                    const int u = __builtin_amdgcn_readfirstlane(*qslot);
                    __syncthreads();
                    if (u >= nlru) break;
                    lru::unit(LP, u, Tseq, (char*)lds_raw);
                }
            }
            if (PHON(17)) {
                const float lam = ((const float*)ctl)[CW_LAM];
                const bf16_t* qb = WSP(bf16_t, WS_Q); const bf16_t* kb_ = WSP(bf16_t, WS_K); const bf16_t* vb = WSP(bf16_t, WS_V); bf16_t* aolo = WSP(bf16_t, WS_AOLO);
                for (int rep = 0; rep < NREP(17); ++rep) for (;;) {
                    if (tid == 0) *qslot = (int)atomicAdd(ctl + CW_QUEUE + 64 * r + 32 + 8 * rep, 1u);
                    __syncthreads();
                    const int a = __builtin_amdgcn_readfirstlane(*qslot);
                    __syncthreads();
                    if (a >= natt) break;
                    const int qi = a % qpb, hh = (a / qpb) & 7, sq = a / (qpb * 8);
                    const size_t row0 = (size_t)sq * Tseq;
                    dattn::unit(qb + (row0 + (size_t)qi * 128) * 1024 + hh * 128, kb_ + row0 * 1024 + hh * 128, vb + row0 * 1024 + hh * 128,
                                aolo + (row0 + (size_t)qi * 128) * 2048 + hh * 128, 2048, Tseq, (char*)lds_raw, lam, INP(I_SUBG));
                }
            }
        }
        SEAM();
        if (ACTIVE() && PHON(4)) for (int rep = 0; rep < NREP(4); ++rep) {
            FRESH();
            pg8::Gemm g{WSP(bf16_t, WS_AOLO), WSP(bf16_t, WS_PATTN), 2048, 2048, 2048}; pg8::StaticOrder S; S.init(RM, 1024, G, bx);
            pg8::EpiGateCat E{WSP(bf16_t, WS_SA), WSP(bf16_t, WS_SL), WSP(bf16_t, WS_MERGED)}; pg8::gemm_phase<true>(lds, g, S, E);
        }
        SEAM();
        if (ACTIVE() && PHON(5)) { FRESH(); pg8::Gemm g{WSP(bf16_t, WS_MERGED), WSP(bf16_t, WS_WMIX), 1024, 1024, 1024}; pg8::StaticOrder S; S.init(RM, 1024, G, bx);
            pg8::EpiResidLN<true> E{XIN(), WSP(float, WS_Y), WSP(bf16_t, WS_X1B), INP(I_LN1G), INP(I_LN1B), {WSP(unsigned long long, WS_LNX), WSP(unsigned, WS_CTL) + CW_LNCNT + ((r * 3 + 0) * 128) * 16}, lds + XLDS_OFF};
            pg8::gemm_phase(lds, g, S, E); }
        SEAM();
        if (ACTIVE() && PHON(7)) { FRESH();
            { pg8::Gemm g{WSP(bf16_t, WS_X1B), WSP(bf16_t, WS_XAQ), 1024, 1024, 1024}; pg8::PmPnOrder S{(RM / 256) * 4, G, bx}; pg8::EpiBf16 E{WSP(bf16_t, WS_QX), 1024, 0.0625f}; pg8::gemm_phase(lds, g, S, E); }
            { pg8::Gemm g{WSP(bf16_t, WS_QX), WSP(bf16_t, WS_KX), 1024, 1024, 256}; pg8::XaOrder<0> S{(RM / 256) * 4, G, bx, tsh, seq0};
              pg8::EpiSoftmax E{WSP(bf16_t, WS_P), (LAS float*)(lds + XLDS_OFF)}; pg8::gemm_phase(lds, g, S, E); }
            { pg8::Gemm g{WSP(bf16_t, WS_P), WSP(bf16_t, WS_VXT), 1024, 256, 256}; pg8::XaOrder<1> S{(RM / 256) * 4, G, bx, tsh, seq0};
              pg8::EpiBf16 E{WSP(bf16_t, WS_OXA), 1024, 1.f}; pg8::gemm_phase(lds, g, S, E); }
        }
        SEAM();
        if (ACTIVE() && PHON(10)) { FRESH(); pg8::Gemm g{WSP(bf16_t, WS_OXA), WSP(bf16_t, WS_XAO), 1024, 1024, 1024}; pg8::StaticOrder S; S.init(RM, 1024, G, bx);
            pg8::EpiResidLN<true> E{WSP(float, WS_Y), WSP(float, WS_Y), WSP(bf16_t, WS_X2B), INP(I_LN2G), INP(I_LN2B), {WSP(unsigned long long, WS_LNX), WSP(unsigned, WS_CTL) + CW_LNCNT + ((r * 3 + 1) * 128) * 16}, lds + XLDS_OFF};
            pg8::gemm_phase(lds, g, S, E); }
        SEAM();
        if (ACTIVE() && PHON(12)) for (int rep = 0; rep < NREP(12); ++rep) { FRESH(); pg8::Gemm g{WSP(bf16_t, WS_X2B), WSP(bf16_t, WS_FFIN), 1024, 1024, 1024}; pg8::StaticOrder S; S.init(RM, 2 * DFF, G, bx); pg8::EpiSwiglu E{WSP(bf16_t, WS_HFF)}; pg8::gemm_phase(lds, g, S, E); }
        SEAM();
        if (ACTIVE() && PHON(13)) { FRESH(); pg8::Gemm g{WSP(bf16_t, WS_HFF), WSP(bf16_t, WS_FFOUT), DFF, DFF, DFF}; pg8::StaticOrder S; S.init(RM, 1024, G, bx);
            pg8::EpiResidLN<false> E{WSP(float, WS_Y), OUTR(), nullptr, INP(I_LN3G), INP(I_LN3B), {WSP(unsigned long long, WS_LNX), WSP(unsigned, WS_CTL) + CW_LNCNT + ((r * 3 + 2) * 128) * 16}, lds + XLDS_OFF};
            pg8::gemm_phase(lds, g, S, E); }
        SEAM();
    }
#undef SEAM
#undef ACTIVE
}

extern "C" void kernel_launch(void* const* d_in, const int* in_sizes, int n_in, void* d_out, int out_size, void* d_ws, size_t ws_size, hipStream_t stream) {
    static int grid = 0;
    if (grid == 0) {
        if (n_in != 31 || out_size != NTOK * 1024 || ws_size < WS_END) { fprintf(stderr, "kernel_launch: unexpected shapes n_in %d out %d ws %zu\n", n_in, out_size, ws_size); grid = -1; return; }
        int dev = 0, cus = 0, per_cu = 0;
        hipGetDevice(&dev); hipDeviceGetAttribute(&cus, hipDeviceAttributeMultiprocessorCount, dev);
        if (hipFuncSetAttribute((const void*)mk_fwd, hipFuncAttributeMaxDynamicSharedMemorySize, LDS_BYTES) != hipSuccess) { fprintf(stderr, "kernel_launch: hipFuncSetAttribute failed\n"); grid = -1; return; }
        hipOccupancyMaxActiveBlocksPerMultiprocessor(&per_cu, (const void*)mk_fwd, NTHREADS, LDS_BYTES);
        (void)hipGetLastError();
        if (per_cu < 1) per_cu = 1;
        grid = cus * 1;
        fprintf(stderr, "kernel_launch: cus %d per_cu %d grid %d\n", cus, per_cu, grid);
    }
    if (grid < 0) return;
    if (hipMemsetAsync((char*)d_ws + WS_CTL, 0, CTL_ZERO_BYTES, stream) != hipSuccess) { fprintf(stderr, "kernel_launch: memset failed\n"); return; }
    Args a{};
    for (int i = 0; i < 31; ++i) a.in[i] = (const float*)d_in[i];
    a.out = (float*)d_out; a.ws = (unsigned char*)d_ws; a.ph_lo = 0; a.ph_hi = 1000;
    void* kargs[] = {&a};
    hipError_t e = hipLaunchCooperativeKernel((const void*)mk_fwd, dim3(grid), dim3(NTHREADS), kargs, LDS_BYTES, stream);
    if (e != hipSuccess) fprintf(stderr, "kernel_launch: cooperative launch failed: %s (grid %d)\n", hipGetErrorString(e), grid);
}
```

```cpp
#include <hip/hip_runtime.h>
#include <hip/hip_cooperative_groups.h>
#include <cstdio>
#include <cstdint>
namespace cg = cooperative_groups;

#define LAS __attribute__((address_space(3)))
#define GAS __attribute__((address_space(1)))
typedef unsigned short bf16_t;
typedef short bf16x8 __attribute__((ext_vector_type(8)));
typedef short s16x4 __attribute__((ext_vector_type(4)));
typedef float f32x4 __attribute__((ext_vector_type(4)));
typedef float f32x2 __attribute__((ext_vector_type(2)));
typedef float f32x16 __attribute__((ext_vector_type(16)));
typedef unsigned u32x4 __attribute__((ext_vector_type(4)));
typedef unsigned u32x2 __attribute__((ext_vector_type(2)));

constexpr int DM = 1024, NTOK = 98304, RM = 32768, NROUND = 3, NMEMROW = 9216, DFF = 2816, INW = 7168;
constexpr float ALPHA = 1.189207115002721f;
constexpr float LN_EPS = 1e-5f, SUBLN_EPS = 1e-5f, LAMBDA_INIT = 0.2f;
constexpr int NWAVES = 8, NTHREADS = 512;
constexpr int LDS_BYTES = 147456, RING_BYTES = 131072, XLDS_OFF = RING_BYTES;

constexpr size_t MiB = 1u << 20;
constexpr size_t WS_CTL = 0, WS_ROPE = 1 * MiB;
constexpr size_t WS_WIN = 2 * MiB, WS_PATTN = 16 * MiB, WS_PLRU = 18 * MiB, WS_WMIX = 20 * MiB, WS_XAQ = 22 * MiB, WS_XAO = 24 * MiB, WS_XAKV = 26 * MiB;
constexpr size_t WS_FFIN = 30 * MiB, WS_FFOUT = 41 * MiB, WS_LRUW = 47 * MiB, WS_MEMB = 48 * MiB, WS_KX = 66 * MiB, WS_VXT = 84 * MiB, WS_XB = 104 * MiB;
constexpr size_t WS_Q = 296 * MiB, WS_K = 360 * MiB, WS_V = 424 * MiB, WS_XR = 488 * MiB, WS_GYR = 552 * MiB, WS_SA = 616 * MiB, WS_SL = 680 * MiB, WS_AOLO = 744 * MiB;
constexpr size_t SEG_STRIDE = 64 * MiB / 2;
constexpr size_t WS_MERGED = 296 * MiB, WS_TMP = 360 * MiB, WS_Y = 488 * MiB, WS_X1B = 872 * MiB, WS_QX = 936 * MiB, WS_P = 616 * MiB, WS_OXA = 680 * MiB;
constexpr size_t WS_X2B = 296 * MiB, WS_HFF = 744 * MiB, WS_LNX = 1000 * MiB, WS_END = 1002 * MiB;
constexpr int CW_QUEUE = 64;
constexpr int CW_LAM = 16;
constexpr int CW_BAR = 4096;
constexpr size_t CTL_ZERO_BYTES = 131072;
constexpr int CW_LNCNT = 8192;

__device__ __forceinline__ unsigned cvt_pk_bf16(float lo, float hi) { unsigned r; asm volatile("v_cvt_pk_bf16_f32 %0, %1, %2" : "=v"(r) : "v"(lo), "v"(hi)); return r; }
__device__ __forceinline__ float bf2f(unsigned short b) { return __uint_as_float(((unsigned)b) << 16); }
__device__ __forceinline__ float sigmoidf_(float x) { return __builtin_amdgcn_rcpf(1.f + __builtin_amdgcn_exp2f(-1.4426950408889634f * x)); }
__device__ __forceinline__ float gelu_tanh(float x) { const float u = 0.7978845608028654f * (x + 0.044715f * x * x * x); return x * sigmoidf_(2.f * u); }
__device__ __forceinline__ float wave_sum(float v) {
#pragma unroll
    for (int o = 1; o < 64; o <<= 1) v += __shfl_xor(v, o);
    return v;
}

namespace pg8 {
constexpr int BM = 256, BK = 64, HALF = 128, HTB = HALF * BK * 2, STAGE_BYTES = 8 * HTB, NXCD = 8, WGM = 8;
__host__ __device__ __forceinline__ int lds_byte(int r, int c) { const int st = (r >> 4) * 2 + (c >> 5), rr = r & 15, cc = c & 31, ob = rr * 64 + cc * 2; return st * 1024 + (ob ^ (((ob >> 9) & 1) << 5)); }
__host__ __device__ __forceinline__ void stage_rc(int b, int& R, int& C) { const int st = b / 1024, sb = b % 1024, swz = sb ^ (((sb >> 9) & 1) << 5); R = (st >> 1) * 16 + swz / 64; C = (st & 1) * 32 + (swz % 64) / 2; }
__host__ __device__ __forceinline__ int perm32(int rho) { const int n = rho >> 4, i = rho & 15; return 8 * (i >> 2) + 4 * n + (i & 3); }

struct Unit { int pm, pn; };
struct Gemm { const bf16_t* A; const bf16_t* Bt; int lda, ldb, K; };

struct StaticOrder {
    int nM, nN, nwg, G, c;
    __device__ void init(int M, int N, int G_, int c_) { nM = M / BM; nN = N / BM; nwg = nM * nN; G = G_; c = c_; }
    __device__ bool next(int i, Unit& u) const {
        const long L = (long)i * G + c; if (L >= nwg) return false;
        int wgid = (int)L; { const int q = nwg / NXCD, r = nwg % NXCD, xcd = wgid % NXCD, off = wgid / NXCD; wgid = (xcd < r ? xcd * (q + 1) : r * (q + 1) + (xcd - r) * q) + off; }
        const int nig = WGM * nN, gid = wgid / nig, fm = gid * WGM, gsz = (nM - fm) < WGM ? (nM - fm) : WGM;
        u.pm = fm + ((wgid % nig) % gsz); u.pn = (wgid % nig) / gsz; return true;
    }
    __device__ __forceinline__ const char* a_base(const Gemm& g, const Unit& u) const { return (const char*)(g.A + (size_t)u.pm * BM * g.lda); }
    __device__ __forceinline__ const char* b_base(const Gemm& g, const Unit& u) const { return (const char*)(g.Bt + (size_t)u.pn * BM * g.ldb); }
};
template <int MODE> struct XaOrder {
    int nwg, G, c, tshift  , seq0;
    __device__ bool next(int i, Unit& u) const { const long L = (long)i * G + c; if (L >= nwg) return false; u.pm = (int)(L >> 2); u.pn = (int)(L & 3); return true; }
    __device__ __forceinline__ const char* a_base(const Gemm& g, const Unit& u) const { return (const char*)(g.A + (size_t)u.pm * BM * g.lda + u.pn * 256); }
    __device__ __forceinline__ const char* b_base(const Gemm& g, const Unit& u) const {
        const int sq = seq0 + (u.pm >> tshift);
        return MODE == 0 ? (const char*)(g.Bt + (size_t)sq * 256 * 1024 + u.pn * 256) : (const char*)(g.Bt + (size_t)(sq * 4 + u.pn) * 65536);
    }
};

struct PmPnOrder {
    int nwg, G, c;
    __device__ bool next(int i, Unit& u) const { const long L = (long)i * G + c; if (L >= nwg) return false; u.pm = (int)(L >> 2); u.pn = (int)(L & 3); return true; }
    __device__ __forceinline__ const char* a_base(const Gemm& g, const Unit& u) const { return (const char*)(g.A + (size_t)u.pm * BM * g.lda); }
    __device__ __forceinline__ const char* b_base(const Gemm& g, const Unit& u) const { return (const char*)(g.Bt + (size_t)u.pn * BM * g.ldb); }
};
template <bool HOOK = false, class Epi, class Sched>
__device__ __forceinline__ void gemm_phase(LAS unsigned char* lds, const Gemm g, const Sched& S, const Epi& E) {
    int tid = threadIdx.x; asm volatile("" : "+v"(tid));
    const int wid = __builtin_amdgcn_readfirstlane(tid >> 6), lane = tid & 63, wr = wid >> 2, wc = wid & 3, fr = lane & 15, fq = lane >> 4;
    int lda = g.lda, ldb = g.ldb, K = g.K; asm volatile("" : "+s"(lda), "+s"(ldb), "+s"(K));
    const int nt = K / BK;
    unsigned voffA[2], voffB[2];
#pragma unroll
    for (int i = 0; i < 2; ++i) { int R, C; stage_rc(tid * 16 + i * 8192, R, C); const int Rb = (R & ~31) + perm32(R & 31);
        voffA[i] = (unsigned)(R * lda + C) * 2u; voffB[i] = (unsigned)(Rb * ldb + C) * 2u; }
    const size_t kstep = (size_t)(BK * 2);
    const size_t hstA = (size_t)HALF * lda * 2, hstB = (size_t)HALF * ldb * 2;
    const unsigned ldsw = (unsigned)wid * 1024u;
    const int aoff = lds_byte(wr * 64 + fr, fq * 8), boff = lds_byte(wc * 32 + fr, fq * 8);
#define PG8_SA(b, h) (((b) * 2 + (h)) * HTB)
#define PG8_SB(b, h) ((4 + (b) * 2 + (h)) * HTB)
#define PG8_STAGE(bufoff, gbase, voff) do { _Pragma("unroll") for (int _i = 0; _i < 2; ++_i) \
        __builtin_amdgcn_global_load_lds((const unsigned*)((const char*)(gbase) + (voff)[_i]), (LAS unsigned*)(lds + (bufoff) + ldsw + _i * 8192), 16, 0, 0); } while (0)
#define PG8_LDA(dst, b, h) do { _Pragma("unroll") for (int m = 0; m < 4; ++m) _Pragma("unroll") for (int k = 0; k < 2; ++k) dst[m][k] = *(const LAS bf16x8*)(lds + PG8_SA(b, h) + aoff + m * 2048 + k * 1024); } while (0)
#define PG8_LDB(dst, b, h) do { _Pragma("unroll") for (int n = 0; n < 2; ++n) _Pragma("unroll") for (int k = 0; k < 2; ++k) dst[n][k] = *(const LAS bf16x8*)(lds + PG8_SB(b, h) + boff + n * 2048 + k * 1024); } while (0)
#define PG8_MMA(ai, bj, At, Bt) do { __builtin_amdgcn_s_setprio(1); _Pragma("unroll") for (int m = 0; m < 4; ++m) _Pragma("unroll") for (int n = 0; n < 2; ++n) _Pragma("unroll") for (int k = 0; k < 2; ++k) \
        acc[ai][bj][m][n] = __builtin_amdgcn_mfma_f32_16x16x32_bf16(Bt[n][k], At[m][k], acc[ai][bj][m][n], 0, 0, 0); __builtin_amdgcn_s_setprio(0); } while (0)
#define PG8_WAIT_V(n) asm volatile("s_waitcnt vmcnt(" #n ")" ::: "memory")
#define PG8_WAIT_L(n) asm volatile("s_waitcnt lgkmcnt(" #n ")" ::: "memory")
#define PG8_BAR __builtin_amdgcn_s_barrier()
#define PG8_SCHED __builtin_amdgcn_sched_barrier(0)
    Unit cur, nxt; int ui = 0;
    if (!S.next(0, cur)) return;
    f32x4 acc[2][2][4][2];
#pragma unroll
    for (int a = 0; a < 2; ++a)
#pragma unroll
        for (int b = 0; b < 2; ++b)
#pragma unroll
            for (int m = 0; m < 4; ++m)
#pragma unroll
                for (int n = 0; n < 2; ++n) acc[a][b][m][n] = (f32x4){0.f, 0.f, 0.f, 0.f};
    bf16x8 At[4][2], B0[2][2], B1[2][2];
    const char* cA = S.a_base(g, cur); const char* cB = S.b_base(g, cur);
    PG8_STAGE(PG8_SB(0, 0), cB, voffB); PG8_STAGE(PG8_SB(0, 1), cB + hstB, voffB); PG8_STAGE(PG8_SA(0, 0), cA, voffA); PG8_STAGE(PG8_SA(0, 1), cA + hstA, voffA);
    if (wr == 1) PG8_BAR;
    PG8_WAIT_V(2); PG8_BAR;
    PG8_STAGE(PG8_SB(1, 0), cB + kstep, voffB); PG8_STAGE(PG8_SA(1, 0), cA + kstep, voffA); PG8_STAGE(PG8_SB(1, 1), cB + hstB + kstep, voffB);
    PG8_WAIT_V(6); PG8_BAR;
    for (;;) {
        const bool has_next = S.next(ui + 1, nxt);
        const char* nA = has_next ? S.a_base(g, nxt) : cA; const char* nB = has_next ? S.b_base(g, nxt) : cB;
        for (int t = 0; t < nt; t += 2) {
            if constexpr (HOOK) { if (t == (nt >> 1)) { E.mid(acc, cur, wr, wc, fr, fq); PG8_WAIT_V(0); } }
            const bool last = (t == nt - 2);
            const char* a1 = cA + (size_t)(t + 1) * kstep;
            const char* a2 = last ? nA : cA + (size_t)(t + 2) * kstep; const char* b2 = last ? nB : cB + (size_t)(t + 2) * kstep;
            const char* a3 = a2 + kstep; const char* b3 = b2 + kstep;
            PG8_LDB(B0, 0, 0); PG8_LDB(B1, 0, 1); PG8_SCHED; PG8_LDA(At, 0, 0); PG8_STAGE(PG8_SA(1, 1), a1 + hstA, voffA);
            PG8_WAIT_V(8); PG8_WAIT_L(0); PG8_BAR; PG8_MMA(0, 0, At, B0); PG8_MMA(0, 1, At, B1); PG8_BAR; PG8_SCHED;
            PG8_LDA(At, 0, 1); PG8_STAGE(PG8_SB(0, 0), b2, voffB); PG8_STAGE(PG8_SB(0, 1), b2 + hstB, voffB); PG8_STAGE(PG8_SA(0, 0), a2, voffA);
            PG8_WAIT_V(8); PG8_WAIT_L(0); PG8_BAR; PG8_MMA(1, 0, At, B0); PG8_MMA(1, 1, At, B1); PG8_BAR; PG8_SCHED;
            PG8_LDB(B0, 1, 0); PG8_LDB(B1, 1, 1); PG8_SCHED; PG8_LDA(At, 1, 0); PG8_STAGE(PG8_SA(0, 1), a2 + hstA, voffA);
            PG8_WAIT_V(8); PG8_WAIT_L(0); PG8_BAR; PG8_MMA(0, 0, At, B0); PG8_MMA(0, 1, At, B1); PG8_BAR; PG8_SCHED;
            PG8_LDA(At, 1, 1); PG8_STAGE(PG8_SB(1, 0), b3, voffB); PG8_STAGE(PG8_SB(1, 1), b3 + hstB, voffB); PG8_STAGE(PG8_SA(1, 0), a3, voffA);
            PG8_WAIT_V(8); PG8_WAIT_L(0); PG8_BAR; PG8_MMA(1, 0, At, B0); PG8_MMA(1, 1, At, B1); PG8_BAR; PG8_SCHED;
        }
        if (wr == 0) PG8_BAR;
        E(acc, cur, wr, wc, fr, fq);
        if (!has_next) break;
#pragma unroll
        for (int a = 0; a < 2; ++a)
#pragma unroll
            for (int b = 0; b < 2; ++b)
#pragma unroll
                for (int m = 0; m < 4; ++m)
#pragma unroll
                    for (int n = 0; n < 2; ++n) acc[a][b][m][n] = (f32x4){0.f, 0.f, 0.f, 0.f};
        cur = nxt; cA = nA; cB = nB; ++ui;
        if (wr == 1) PG8_BAR;
    }
    PG8_WAIT_V(0);
    PG8_BAR;
#undef PG8_SA
#undef PG8_SB
#undef PG8_STAGE
#undef PG8_LDA
#undef PG8_LDB
#undef PG8_MMA
#undef PG8_WAIT_V
#undef PG8_WAIT_L
#undef PG8_BAR
#undef PG8_SCHED
}

typedef f32x4 Acc[2][2][4][2];
__device__ __forceinline__ void st8(bf16_t* p, f32x4 v0, f32x4 v1) { u32x4 w; w.x = cvt_pk_bf16(v0[0], v0[1]); w.y = cvt_pk_bf16(v0[2], v0[3]); w.z = cvt_pk_bf16(v1[0], v1[1]); w.w = cvt_pk_bf16(v1[2], v1[3]); *(u32x4*)p = w; }

struct EpiProj {
    bf16_t* out; const float* rope; int tmask;
    __device__ __forceinline__ void operator()(const Acc& acc, const Unit& u, int wr, int wc, int fr, int fq) const {
        const int seg = u.pn >> 2, colt = (u.pn & 3) * 256;
        bf16_t* base = out + (size_t)seg * SEG_STRIDE;
        const bool do_rope = (seg < 2) && ((wc & 1) == 0);
#pragma unroll
        for (int ai = 0; ai < 2; ++ai)
#pragma unroll
            for (int m = 0; m < 4; ++m) {
                const int row = u.pm * BM + ai * HALF + wr * 64 + m * 16 + fr;
                f32x4 cs0, cs1, sn0, sn1;
                if (do_rope) { const float* rp = rope + (size_t)(row & tmask) * 16; cs0 = *(const f32x4*)rp; cs1 = *(const f32x4*)(rp + 4); sn0 = *(const f32x4*)(rp + 8); sn1 = *(const f32x4*)(rp + 12);
                    if (fq == 0) { sn0 = -sn0; sn1 = -sn1; } }
#pragma unroll
                for (int bj = 0; bj < 2; ++bj) {
                    f32x4 v0 = acc[ai][bj][m][0], v1 = acc[ai][bj][m][1];
                    if (seg < 2) {
                        if (do_rope) {
                            f32x4 p0, p1;
#pragma unroll
                            for (int j = 0; j < 4; ++j) { p0[j] = __shfl_xor(v0[j], 16); p1[j] = __shfl_xor(v1[j], 16); }
                            if (fq < 2) { v0 = v0 * cs0 + p0 * sn0; v1 = v1 * cs1 + p1 * sn1; }
                        }
                        if (seg == 0) { v0 = v0 * 0.18033688011112042f; v1 = v1 * 0.18033688011112042f; }
                    } else if (seg == 4) {
#pragma unroll
                        for (int j = 0; j < 4; ++j) { v0[j] = gelu_tanh(v0[j]); v1[j] = gelu_tanh(v1[j]); }
                    } else if (seg >= 5) {
#pragma unroll
                        for (int j = 0; j < 4; ++j) { v0[j] = sigmoidf_(v0[j]); v1[j] = sigmoidf_(v1[j]); }
                    }
                    st8(base + (size_t)row * 1024 + colt + bj * HALF + wc * 32 + 8 * fq, v0, v1);
                }
            }
    }
};
struct EpiKV {
    bf16_t* Kx; bf16_t* VxT;
    __device__ __forceinline__ void operator()(const Acc& acc, const Unit& u, int wr, int wc, int fr, int fq) const {
#pragma unroll
        for (int ai = 0; ai < 2; ++ai)
#pragma unroll
            for (int m = 0; m < 4; ++m) {
                const int row = u.pm * BM + ai * HALF + wr * 64 + m * 16 + fr;
#pragma unroll
                for (int bj = 0; bj < 2; ++bj) {
                    const f32x4 v0 = acc[ai][bj][m][0], v1 = acc[ai][bj][m][1];
                    const int col = u.pn * BM + bj * HALF + wc * 32 + 8 * fq;
                    if (u.pn < 4) st8(Kx + (size_t)row * 1024 + col, v0, v1);
                    else { const int c = col - 1024, h = c >> 8, dd = c & 255, key = row & 255, sq = row >> 8;
                        bf16_t* p = VxT + ((size_t)(sq * 4 + h) * 256 + dd) * 256 + key;
#pragma unroll
                        for (int j = 0; j < 4; ++j) { p[(size_t)j * 256] = (bf16_t)(cvt_pk_bf16(v0[j], 0.f) & 0xffffu); p[(size_t)(4 + j) * 256] = (bf16_t)(cvt_pk_bf16(v1[j], 0.f) & 0xffffu); } }
                }
            }
    }
};
__device__ __forceinline__ void unpack8(const u32x4 w, f32x4& a, f32x4& b) {
    a = (f32x4){__uint_as_float(w.x << 16), __uint_as_float(w.x & 0xffff0000u), __uint_as_float(w.y << 16), __uint_as_float(w.y & 0xffff0000u)};
    b = (f32x4){__uint_as_float(w.z << 16), __uint_as_float(w.z & 0xffff0000u), __uint_as_float(w.w << 16), __uint_as_float(w.w & 0xffff0000u)};
}
struct EpiGateCat {
    const bf16_t* sa; const bf16_t* sl; bf16_t* out;
    __device__ __forceinline__ static f32x4 ratio4(unsigned a01, unsigned a23, unsigned l01, unsigned l23) {
        f32x4 r;
        r[0] = __uint_as_float(a01 << 16) * __builtin_amdgcn_rcpf(fmaxf(__uint_as_float(l01 << 16), 8.6736174e-19f));
        r[1] = __uint_as_float(a01 & 0xffff0000u) * __builtin_amdgcn_rcpf(fmaxf(__uint_as_float(l01 & 0xffff0000u), 8.6736174e-19f));
        r[2] = __uint_as_float(a23 << 16) * __builtin_amdgcn_rcpf(fmaxf(__uint_as_float(l23 << 16), 8.6736174e-19f));
        r[3] = __uint_as_float(a23 & 0xffff0000u) * __builtin_amdgcn_rcpf(fmaxf(__uint_as_float(l23 & 0xffff0000u), 8.6736174e-19f));
        return r;
    }
    __device__ __forceinline__ void mid(Acc& acc, const Unit& u, int wr, int wc, int fr, int fq) const {
        const GAS bf16_t* sa = (const GAS bf16_t*)this->sa; const GAS bf16_t* sl = (const GAS bf16_t*)this->sl; asm volatile("" : "+s"(sa), "+s"(sl));
#pragma unroll
        for (int ai = 0; ai < 2; ++ai)
#pragma unroll
            for (int mp = 0; mp < 2; ++mp) {
                u32x4 wa[2][2], wl[2][2];
#pragma unroll
                for (int mm = 0; mm < 2; ++mm) { const int m = mp * 2 + mm; const int row = u.pm * BM + ai * HALF + wr * 64 + m * 16 + fr;
#pragma unroll
                    for (int bj = 0; bj < 2; ++bj) { const size_t off = (size_t)row * 1024 + u.pn * BM + bj * HALF + wc * 32 + 8 * fq;
                        wa[mm][bj] = *(const GAS u32x4*)(sa + off); wl[mm][bj] = *(const GAS u32x4*)(sl + off); } }
#pragma unroll
                for (int mm = 0; mm < 2; ++mm) { const int m = mp * 2 + mm;
#pragma unroll
                    for (int bj = 0; bj < 2; ++bj) {
                        acc[ai][bj][m][0] = acc[ai][bj][m][0] * ratio4(wa[mm][bj].x, wa[mm][bj].y, wl[mm][bj].x, wl[mm][bj].y);
                        acc[ai][bj][m][1] = acc[ai][bj][m][1] * ratio4(wa[mm][bj].z, wa[mm][bj].w, wl[mm][bj].z, wl[mm][bj].w);
                        asm volatile("" : "+v"(acc[ai][bj][m][0]), "+v"(acc[ai][bj][m][1]));
                    } }
                asm volatile("" ::: "memory");
            }
    }
    __device__ __forceinline__ void operator()(const Acc& acc, const Unit& u, int wr, int wc, int fr, int fq) const {
#pragma unroll
        for (int ai = 0; ai < 2; ++ai) {
            u32x4 wl[4][2];
#pragma unroll
            for (int m = 0; m < 4; ++m) { const int row = u.pm * BM + ai * HALF + wr * 64 + m * 16 + fr;
#pragma unroll
                for (int bj = 0; bj < 2; ++bj) wl[m][bj] = *(const u32x4*)(sl + (size_t)row * 1024 + u.pn * BM + bj * HALF + wc * 32 + 8 * fq); }
#pragma unroll
            for (int m = 0; m < 4; ++m) { const int row = u.pm * BM + ai * HALF + wr * 64 + m * 16 + fr;
#pragma unroll
                for (int bj = 0; bj < 2; ++bj) {
                    const size_t off = (size_t)row * 1024 + u.pn * BM + bj * HALF + wc * 32 + 8 * fq;
                    f32x4 l0, l1; unpack8(wl[m][bj], l0, l1);
#pragma unroll
                    for (int j = 0; j < 4; ++j) { l0[j] = fmaxf(l0[j], 8.6736174e-19f); l1[j] = fmaxf(l1[j], 8.6736174e-19f); }
                    st8(out + off, acc[ai][bj][m][0] * l0, acc[ai][bj][m][1] * l1);
                }
            }
            asm volatile("" ::: "memory");
        }
    }
};
struct EpiResid {
    const float* res; float* y;
    __device__ __forceinline__ void operator()(const Acc& acc, const Unit& u, int wr, int wc, int fr, int fq) const {
#pragma unroll
        for (int ai = 0; ai < 2; ++ai)
#pragma unroll
            for (int m = 0; m < 4; ++m) {
                const int row = u.pm * BM + ai * HALF + wr * 64 + m * 16 + fr;
#pragma unroll
                for (int bj = 0; bj < 2; ++bj) {
                    const size_t off = (size_t)row * 1024 + u.pn * BM + bj * HALF + wc * 32 + 8 * fq;
                    const f32x4 r0 = *(const f32x4*)(res + off), r1 = *(const f32x4*)(res + off + 4);
                    *(f32x4*)(y + off) = r0 * ALPHA + acc[ai][bj][m][0]; *(f32x4*)(y + off + 4) = r1 * ALPHA + acc[ai][bj][m][1];
                }
                asm volatile("" ::: "memory");
            }
    }
};
struct EpiBf16 {
    bf16_t* out; int ldc; float scale;
    __device__ __forceinline__ void operator()(const Acc& acc, const Unit& u, int wr, int wc, int fr, int fq) const {
#pragma unroll
        for (int ai = 0; ai < 2; ++ai)
#pragma unroll
            for (int m = 0; m < 4; ++m) {
                const int row = u.pm * BM + ai * HALF + wr * 64 + m * 16 + fr;
#pragma unroll
                for (int bj = 0; bj < 2; ++bj)
                    st8(out + (size_t)row * ldc + u.pn * BM + bj * HALF + wc * 32 + 8 * fq, acc[ai][bj][m][0] * scale, acc[ai][bj][m][1] * scale);
                asm volatile("" ::: "memory");
            }
    }
};
struct EpiSwiglu {
    bf16_t* out;
    __device__ __forceinline__ void operator()(const Acc& acc, const Unit& u, int wr, int wc, int fr, int fq) const {
#pragma unroll
        for (int ai = 0; ai < 2; ++ai)
#pragma unroll
            for (int m = 0; m < 4; ++m) {
                const int row = u.pm * BM + ai * HALF + wr * 64 + m * 16 + fr;
                f32x4 h0, h1;
#pragma unroll
                for (int j = 0; j < 4; ++j) { const float g0 = acc[ai][0][m][0][j], g1 = acc[ai][0][m][1][j];
                    h0[j] = g0 * sigmoidf_(g0) * acc[ai][1][m][0][j]; h1[j] = g1 * sigmoidf_(g1) * acc[ai][1][m][1][j]; }
                st8(out + (size_t)row * DFF + u.pn * HALF + wc * 32 + 8 * fq, h0, h1);
            }
    }
};
struct EpiSoftmax {
    bf16_t* P; LAS float* xl;
    __device__ __forceinline__ void operator()(Acc& acc, const Unit& u, int wr, int wc, int fr, int fq) const {
        constexpr float L2E = 1.4426950408889634f;
        LAS float* xw = xl + ((wr * 64 + fr) * 4 + wc) * 2; const LAS float* xr_ = xl + (wr * 64 + fr) * 8;
#pragma unroll
        for (int ai = 0; ai < 2; ++ai)
#pragma unroll
            for (int m = 0; m < 4; ++m) {
                float mx = -3.0e38f;
#pragma unroll
                for (int bj = 0; bj < 2; ++bj)
#pragma unroll
                    for (int n = 0; n < 2; ++n)
#pragma unroll
                        for (int j = 0; j < 4; ++j) mx = fmaxf(mx, acc[ai][bj][m][n][j]);
                mx = fmaxf(mx, __shfl_xor(mx, 16)); mx = fmaxf(mx, __shfl_xor(mx, 32));
                float s = 0.f;
#pragma unroll
                for (int bj = 0; bj < 2; ++bj)
#pragma unroll
                    for (int n = 0; n < 2; ++n)
#pragma unroll
                        for (int j = 0; j < 4; ++j) { const float e = __builtin_amdgcn_exp2f((acc[ai][bj][m][n][j] - mx) * L2E); acc[ai][bj][m][n][j] = e; s += e; }
                s += __shfl_xor(s, 16); s += __shfl_xor(s, 32);
                if (fq == 0) { xw[(ai * HALF + m * 16) * 8] = mx; xw[(ai * HALF + m * 16) * 8 + 1] = s; }
                asm volatile("" ::: "memory");
            }
        asm volatile("s_waitcnt lgkmcnt(0)" ::: "memory"); __builtin_amdgcn_s_barrier(); asm volatile("" ::: "memory");
#pragma unroll
        for (int ai = 0; ai < 2; ++ai)
#pragma unroll
            for (int m = 0; m < 4; ++m) {
                const int r = ai * HALF + wr * 64 + m * 16 + fr; const int row = u.pm * BM + r;
                const f32x4 a = *(const LAS f32x4*)(xr_ + (ai * HALF + m * 16) * 8), b = *(const LAS f32x4*)(xr_ + (ai * HALF + m * 16) * 8 + 4);
                const float M = fmaxf(fmaxf(a[0], a[2]), fmaxf(b[0], b[2]));
                const float tot = a[1] * __builtin_amdgcn_exp2f((a[0] - M) * L2E) + a[3] * __builtin_amdgcn_exp2f((a[2] - M) * L2E) + b[1] * __builtin_amdgcn_exp2f((b[0] - M) * L2E) + b[3] * __builtin_amdgcn_exp2f((b[2] - M) * L2E);
                const float mown = wc == 0 ? a[0] : wc == 1 ? a[2] : wc == 2 ? b[0] : b[2];
                const float f = __builtin_amdgcn_exp2f((mown - M) * L2E) * __builtin_amdgcn_rcpf(tot);
#pragma unroll
                for (int bj = 0; bj < 2; ++bj)
                    st8(P + (size_t)row * 1024 + u.pn * BM + bj * HALF + wc * 32 + 8 * fq, acc[ai][bj][m][0] * f, acc[ai][bj][m][1] * f);
                asm volatile("" ::: "memory");
            }
        asm volatile("s_waitcnt lgkmcnt(0)" ::: "memory"); __builtin_amdgcn_s_barrier(); asm volatile("" ::: "memory");
    }
};

struct LnStats { unsigned long long* xbuf; unsigned* cnt; };
template <bool WB> struct EpiResidLN {
    const float* res; float* yf; bf16_t* yb; const float* g; const float* b; LnStats st; LAS unsigned char* xl;
    __device__ __forceinline__ void operator()(Acc& acc, const Unit& u, int wr, int wc, int fr, int fq) const {
        const int wid = wr * 4 + wc, lane = fq * 16 + fr;
        LAS f32x2* P = (LAS f32x2*)xl; LAS f32x2* S = (LAS f32x2*)(xl + 8192); LAS unsigned* flag = (LAS unsigned*)(xl + 8192 + 2048);
#pragma unroll
        for (int ai = 0; ai < 2; ++ai) {
            f32x4 rv[4][2][2];
#pragma unroll
            for (int m = 0; m < 4; ++m) {
                const int row = u.pm * BM + ai * HALF + wr * 64 + m * 16 + fr;
#pragma unroll
                for (int bj = 0; bj < 2; ++bj) {
                    const size_t off = (size_t)row * 1024 + u.pn * BM + bj * HALF + wc * 32 + 8 * fq;
                    rv[m][bj][0] = *(const f32x4*)(res + off); rv[m][bj][1] = *(const f32x4*)(res + off + 4);
                }
            }
#pragma unroll
            for (int m = 0; m < 4; ++m) {
#pragma unroll
                for (int bj = 0; bj < 2; ++bj) { acc[ai][bj][m][0] = rv[m][bj][0] * ALPHA + acc[ai][bj][m][0]; acc[ai][bj][m][1] = rv[m][bj][1] * ALPHA + acc[ai][bj][m][1]; }
                asm volatile("" : "+v"(acc[ai][0][m][0]), "+v"(acc[ai][0][m][1]), "+v"(acc[ai][1][m][0]), "+v"(acc[ai][1][m][1]));
            }
            asm volatile("" ::: "memory");
        }
        f32x4 gv[2][2], bv[2][2];
#pragma unroll
        for (int bj = 0; bj < 2; ++bj)
#pragma unroll
            for (int n = 0; n < 2; ++n) { const int col = u.pn * BM + bj * HALF + wc * 32 + 8 * fq + 4 * n; gv[bj][n] = *(const f32x4*)(g + col); bv[bj][n] = *(const f32x4*)(b + col); }
#pragma unroll
        for (int ai = 0; ai < 2; ++ai)
#pragma unroll
            for (int m = 0; m < 4; ++m) {
                float s = 0.f;
#pragma unroll
                for (int bj = 0; bj < 2; ++bj)
#pragma unroll
                    for (int n = 0; n < 2; ++n) { const f32x4 x = acc[ai][bj][m][n]; s += (x[0] + x[1]) + (x[2] + x[3]); }
                s += __shfl_xor(s, 16); s += __shfl_xor(s, 32);
                const float mw = s * (1.0f / 64.0f); float q = 0.f;
#pragma unroll
                for (int bj = 0; bj < 2; ++bj)
#pragma unroll
                    for (int n = 0; n < 2; ++n) { const f32x4 d = acc[ai][bj][m][n] - mw; q += (d[0] * d[0] + d[1] * d[1]) + (d[2] * d[2] + d[3] * d[3]); }
                q += __shfl_xor(q, 16); q += __shfl_xor(q, 32);
                if (fq == 0) P[(ai * HALF + wr * 64 + m * 16 + fr) * 4 + wc] = (f32x2){mw, q};
            }
        asm volatile("s_waitcnt lgkmcnt(0)" ::: "memory"); __builtin_amdgcn_s_barrier(); asm volatile("" ::: "memory");
        const int row = wid * 32 + (lane & 31);
        unsigned* cw = st.cnt + 16 * u.pm;
        if (lane < 32) {
            const f32x2 a = P[row * 4 + 0], b2 = P[row * 4 + 1], c = P[row * 4 + 2], d = P[row * 4 + 3];
            const float mt = (a.x + b2.x + c.x + d.x) * 0.25f;
            const float da = a.x - mt, db = b2.x - mt, dc = c.x - mt, dd = d.x - mt;
            const float m2 = (a.y + b2.y) + (c.y + d.y) + 64.0f * ((da * da + db * db) + (dc * dc + dd * dd));
            unsigned long long* slot = st.xbuf + ((size_t)(u.pm * BM + row) * 4 + u.pn);
            __hip_atomic_store(slot, ((unsigned long long)__float_as_uint(m2) << 32) | __float_as_uint(mt), __ATOMIC_RELAXED, __HIP_MEMORY_SCOPE_AGENT);
        }
        asm volatile("s_waitcnt vmcnt(0)" ::: "memory");
        if (lane == 0) __hip_atomic_fetch_add(cw, 1u, __ATOMIC_RELAXED, __HIP_MEMORY_SCOPE_AGENT);
        if (wid == 0) {
            unsigned sp = 0;
            while ((unsigned)__builtin_amdgcn_readfirstlane(__hip_atomic_load(cw, __ATOMIC_RELAXED, __HIP_MEMORY_SCOPE_AGENT)) < 32u) { __builtin_amdgcn_s_sleep(2); if (++sp > (1u << 22)) break; }
            __builtin_amdgcn_fence(__ATOMIC_ACQUIRE, "agent");
            if (lane == 0) flag[0] = 0u;
        }
        asm volatile("s_waitcnt vmcnt(0) lgkmcnt(0)" ::: "memory"); __builtin_amdgcn_s_barrier(); asm volatile("" ::: "memory");
        if (lane < 32) {
            const unsigned long long* slot = st.xbuf + (size_t)(u.pm * BM + row) * 4; float mt[4], m2[4]; float ms = 0.f;
#pragma unroll
            for (int t = 0; t < 4; ++t) { const unsigned long long w = __hip_atomic_load(slot + t, __ATOMIC_RELAXED, __HIP_MEMORY_SCOPE_AGENT); mt[t] = __uint_as_float((unsigned)w); m2[t] = __uint_as_float((unsigned)(w >> 32)); ms += mt[t]; }
            const float mean = ms * 0.25f; float q = 0.f;
#pragma unroll
            for (int t = 0; t < 4; ++t) { const float dm = mt[t] - mean; q += m2[t] + 256.0f * dm * dm; }
            S[row] = (f32x2){mean, rsqrtf(q * (1.f / 1024.f) + LN_EPS)};
        }
        asm volatile("s_waitcnt lgkmcnt(0)" ::: "memory"); __builtin_amdgcn_s_barrier(); asm volatile("" ::: "memory");
#pragma unroll
        for (int ai = 0; ai < 2; ++ai)
#pragma unroll
            for (int m = 0; m < 4; ++m) {
                const int r = ai * HALF + wr * 64 + m * 16 + fr; const f32x2 sr = S[r];
#pragma unroll
                for (int bj = 0; bj < 2; ++bj) {
                    const size_t off = (size_t)(u.pm * BM + r) * 1024 + u.pn * BM + bj * HALF + wc * 32 + 8 * fq;
                    const f32x4 o0 = (acc[ai][bj][m][0] - sr.x) * sr.y * gv[bj][0] + bv[bj][0], o1 = (acc[ai][bj][m][1] - sr.x) * sr.y * gv[bj][1] + bv[bj][1];
                    *(f32x4*)(yf + off) = o0; *(f32x4*)(yf + off + 4) = o1;
                    if (WB) st8(yb + off, o0, o1);
                }
                asm volatile("" ::: "memory");
            }
        asm volatile("s_waitcnt lgkmcnt(0)" ::: "memory"); __builtin_amdgcn_s_barrier(); asm volatile("" ::: "memory");
    }
};
}

namespace dattn {
constexpr int KVBLK = 64, LDK = 1024;
constexpr size_t SHM_V = KVBLK * 128 * 2, SHM_K = KVBLK * 128 * 2;
constexpr int WS_OFF = 2 * SHM_V + 2 * SHM_K, EXCH_OFF = WS_OFF + NWAVES * 64 * 4;
constexpr float THR = 8.f;
#define KSWZ(row, colB) ((row) * 256 + ((colB) ^ (((row) & 7) << 4)))
#define SBAR() __builtin_amdgcn_sched_barrier(0)
__device__ __forceinline__ int crow(int r, int hi) { return (r & 3) + 8 * (r >> 2) + 4 * hi; }
constexpr float THR2 = THR * 1.4426950408889634f;
template <bool FIRST> __device__ __forceinline__ void partialSM(f32x16& p0, f32x16& p1, float& m_reg, f32x16& negm, float& alpha) {
  float pmax = p0[0];
#pragma unroll
  for (int r = 1; r < 16; ++r) pmax = fmaxf(pmax, p0[r]);
#pragma unroll
  for (int r = 0; r < 16; ++r) pmax = fmaxf(pmax, p1[r]);
  { auto rr = __builtin_amdgcn_permlane32_swap(__float_as_uint(pmax), __float_as_uint(pmax), false, false);
    pmax = fmaxf(__uint_as_float(rr[0]), __uint_as_float(rr[1])); }
  if (!FIRST && __builtin_expect(__all(pmax <= THR2), 1)) { alpha = 1.f; }
  else { const float d = FIRST ? pmax : fmaxf(pmax, 0.f); m_reg += d; alpha = FIRST ? 1.f : __builtin_amdgcn_exp2f(-d);
#pragma unroll
    for (int r = 0; r < 16; ++r) { p0[r] -= d; p1[r] -= d; }
#pragma unroll
    for (int r = 0; r < 16; ++r) negm[r] = -m_reg;
    asm volatile("" : "+v"(negm)); }
#pragma unroll
  for (int r = 0; r < 16; ++r) p0[r] = __builtin_amdgcn_exp2f(p0[r]);
}
__device__ __forceinline__ void finishSM(f32x16& p0, f32x16& p1, float alpha, float& l_reg, bf16x8& pa0, bf16x8& pa1, bf16x8& pa2, bf16x8& pa3, bool do_exp = true) {
  if (do_exp) {
#pragma unroll
  for (int r = 0; r < 16; ++r) p1[r] = __builtin_amdgcn_exp2f(p1[r]); }
  float ps = 0;
#pragma unroll
  for (int r = 0; r < 16; ++r) ps += p0[r];
#pragma unroll
  for (int r = 0; r < 16; ++r) ps += p1[r];
  { auto rr = __builtin_amdgcn_permlane32_swap(__float_as_uint(ps), __float_as_uint(ps), false, false);
    ps = __uint_as_float(rr[0]) + __uint_as_float(rr[1]); }
  l_reg = l_reg * alpha + ps;
#define PK4(P, BASE, OUT) do { unsigned a0 = cvt_pk_bf16(P[BASE + 0], P[BASE + 1]), a1 = cvt_pk_bf16(P[BASE + 2], P[BASE + 3]);   \
    unsigned b0 = cvt_pk_bf16(P[BASE + 4], P[BASE + 5]), b1 = cvt_pk_bf16(P[BASE + 6], P[BASE + 7]);                              \
    auto r0 = __builtin_amdgcn_permlane32_swap(a0, b0, false, false); auto r1 = __builtin_amdgcn_permlane32_swap(a1, b1, false, false); \
    u32x4 w = {r0[0], r1[0], r0[1], r1[1]}; OUT = *reinterpret_cast<bf16x8*>(&w); } while (0)
  PK4(p0, 0, pa0); PK4(p0, 8, pa1); PK4(p1, 0, pa2); PK4(p1, 8, pa3);
#undef PK4
}
template <bool FIRST> __device__ __forceinline__ void rowmaxSM(f32x16& p0, f32x16& p1, float& m_reg, f32x16& negm, float& alpha) {
  float pmax = p0[0];
#pragma unroll
  for (int r = 1; r < 16; ++r) pmax = fmaxf(pmax, p0[r]);
#pragma unroll
  for (int r = 0; r < 16; ++r) pmax = fmaxf(pmax, p1[r]);
  { auto rr = __builtin_amdgcn_permlane32_swap(__float_as_uint(pmax), __float_as_uint(pmax), false, false);
    pmax = fmaxf(__uint_as_float(rr[0]), __uint_as_float(rr[1])); }
  if (!FIRST && __builtin_expect(__all(pmax <= THR2), 1)) { alpha = 1.f; }
  else { const float d = FIRST ? pmax : fmaxf(pmax, 0.f); m_reg += d; alpha = FIRST ? 1.f : __builtin_amdgcn_exp2f(-d);
#pragma unroll
    for (int r = 0; r < 16; ++r) { p0[r] -= d; p1[r] -= d; }
#pragma unroll
    for (int r = 0; r < 16; ++r) negm[r] = -m_reg;
    asm volatile("" : "+v"(negm)); }
}
typedef short v4i16_t __attribute__((ext_vector_type(4)));
__device__ __forceinline__ s16x4 vtr(const LAS char* p) { return __builtin_bit_cast(s16x4, __builtin_amdgcn_ds_read_tr16_b64_v4i16((LAS v4i16_t*)p)); }
#define MF32(a, b, c) __builtin_amdgcn_mfma_f32_32x32x16_bf16(a, b, c, 0, 0, 0)
__device__ __forceinline__ void seg1(f32x16& C0, f32x16& C1, const f32x16& P0, const f32x16& P1, float alP, bf16x8& pa0, bf16x8& pa1, bf16x8& pa2, bf16x8& pa3,
                                     const LAS char* Ks, const bf16x8* qr, const f32x16& negm, int r32, int hi, int cofs) {
  unsigned rr[4][2][2];
#define KLD(d0, half) (*reinterpret_cast<const LAS bf16x8*>(Ks + KSWZ((half) * 32 + r32, ((cofs + (d0) * 16 + hi * 8) * 2))))
  bf16x8 kf[4][2];
#pragma unroll
  for (int d0 = 0; d0 < 4; ++d0) { kf[d0][0] = KLD(d0, 0); kf[d0][1] = KLD(d0, 1); }
  SBAR();
#pragma unroll
  for (int d0 = 0; d0 < 4; ++d0) {
    const bf16x8 ka = kf[d0][0], kb = kf[d0][1];
#pragma unroll
    for (int h2 = 0; h2 < 2; ++h2) { const int i = 2 * d0 + h2;
      if (h2 == 0) C0 = MF32(ka, qr[d0], d0 == 0 ? negm : C0); else C1 = MF32(kb, qr[d0], d0 == 0 ? negm : C1);
      { const int g = i >> 1, hf = i & 1, base = (g & 1) * 8 + hf * 2;
        const unsigned a_ = g < 2 ? cvt_pk_bf16(P0[base], P0[base + 1]) : cvt_pk_bf16(P1[base], P1[base + 1]);
        const unsigned b_ = g < 2 ? cvt_pk_bf16(P0[base + 4], P0[base + 5]) : cvt_pk_bf16(P1[base + 4], P1[base + 5]);
        auto r_ = __builtin_amdgcn_permlane32_swap(a_, b_, false, false); rr[g][hf][0] = r_[0]; rr[g][hf][1] = r_[1]; }
      SBAR();
    }
  }
#undef KLD
  { u32x4 w = {rr[0][0][0], rr[0][1][0], rr[0][0][1], rr[0][1][1]}; pa0 = *reinterpret_cast<bf16x8*>(&w); }
  { u32x4 w = {rr[1][0][0], rr[1][1][0], rr[1][0][1], rr[1][1][1]}; pa1 = *reinterpret_cast<bf16x8*>(&w); }
  { u32x4 w = {rr[2][0][0], rr[2][1][0], rr[2][0][1], rr[2][1][1]}; pa2 = *reinterpret_cast<bf16x8*>(&w); }
  { u32x4 w = {rr[3][0][0], rr[3][1][0], rr[3][0][1], rr[3][1][1]}; pa3 = *reinterpret_cast<bf16x8*>(&w); }
}
template <bool EXPS> __device__ __forceinline__ void seg2(f32x16* o, f32x16& ol, const LAS char* vp, bf16x8 pa0, bf16x8 pa1, bf16x8 pa2, bf16x8 pa3, f32x16& C0, f32x16& C1) {
#define VOFF(n, half) ((((n) >> 2) * 512) + (((n) & 3) * 4096) + (half) * 2048)
  constexpr int DEPTH = 4;
  s16x4 lo[DEPTH], hi_[DEPTH];
#pragma unroll
  for (int n = 0; n < DEPTH; ++n) { lo[n] = vtr(vp + VOFF(n, 0)); hi_[n] = vtr(vp + VOFF(n, 1)); }
  SBAR();
#pragma unroll
  for (int n = 0; n < 16; ++n) {
    const int sl = n % DEPTH;
    const bf16x8 vf = (bf16x8){lo[sl][0], lo[sl][1], lo[sl][2], lo[sl][3], hi_[sl][0], hi_[sl][1], hi_[sl][2], hi_[sl][3]};
    const int ks = n & 3, d0 = n >> 2;
    o[d0] = MF32(ks == 0 ? pa0 : ks == 1 ? pa1 : ks == 2 ? pa2 : pa3, vf, o[d0]);
    if (n + DEPTH < 16) { lo[sl] = vtr(vp + VOFF(n + DEPTH, 0)); hi_[sl] = vtr(vp + VOFF(n + DEPTH, 1)); }
    if (EXPS) {
      if (n < 8) { C0[2 * n] = __builtin_amdgcn_exp2f(C0[2 * n]); C0[2 * n + 1] = __builtin_amdgcn_exp2f(C0[2 * n + 1]); asm volatile("" : "+v"(C0)); }
      else { C1[2 * n - 16] = __builtin_amdgcn_exp2f(C1[2 * n - 16]); C1[2 * n - 15] = __builtin_amdgcn_exp2f(C1[2 * n - 15]); asm volatile("" : "+v"(C1)); }
    }
    SBAR();
  }
  { const bf16x8 ones = {0x3F80, 0x3F80, 0x3F80, 0x3F80, 0x3F80, 0x3F80, 0x3F80, 0x3F80};
    ol = MF32(pa0, ones, ol); ol = MF32(pa1, ones, ol); ol = MF32(pa2, ones, ol); ol = MF32(pa3, ones, ol); }
#undef VOFF
}
__device__ __forceinline__ void qkt(f32x16& p0, f32x16& p1, const char* Ks, const bf16x8* qr, int r32, int hi, int cofs, const f32x16& negm) {
#pragma unroll
  for (int d0 = 0; d0 < 4; ++d0) { int cb = (cofs + d0 * 16 + hi * 8) * 2;
    bf16x8 b0 = *reinterpret_cast<const bf16x8*>(Ks + KSWZ(r32, cb));
    bf16x8 b1 = *reinterpret_cast<const bf16x8*>(Ks + KSWZ(32 + r32, cb));
    if (d0 == 0) { p0 = __builtin_amdgcn_mfma_f32_32x32x16_bf16(b0, qr[0], negm, 0, 0, 0); p1 = __builtin_amdgcn_mfma_f32_32x32x16_bf16(b1, qr[0], negm, 0, 0, 0); }
    else { p0 = __builtin_amdgcn_mfma_f32_32x32x16_bf16(b0, qr[d0], p0, 0, 0, 0); p1 = __builtin_amdgcn_mfma_f32_32x32x16_bf16(b1, qr[d0], p1, 0, 0, 0); } }
}
__device__ __forceinline__ int v_st(int k, int c) { const int kk = (k & ~0xC) | ((k & 4) << 1) | ((k & 8) >> 1); return ((kk >> 3) * 4 + (c >> 5)) * 512 + ((kk & 7) * 32 + (c & 31)) * 2; }
__device__ __forceinline__ int v_rd_base(int lane) { return ((lane & 3) << 3) | (((lane >> 2) & 3) << 6) | (((lane >> 4) & 1) << 5) | (((lane >> 5) & 1) << 8); }
constexpr int v_rd_off(int d0, int ks, int half) { return d0 * 512 + ks * 4096 + half * 2048; }
template <int OFF> __device__ __forceinline__ s16x4 tr_read(int vb) {
  s16x4 r; asm volatile("ds_read_b64_tr_b16 %0, %1 offset:%2" : "=&v"(r) : "v"(vb), "i"(OFF) : "memory"); return r;
}
template <int D0> __device__ __forceinline__ void pv_one(f32x16& od, int vb, bf16x8 pa0, bf16x8 pa1, bf16x8 pa2, bf16x8 pa3) {
  const s16x4 l0 = tr_read<v_rd_off(D0, 0, 0)>(vb), h0 = tr_read<v_rd_off(D0, 0, 1)>(vb), l1 = tr_read<v_rd_off(D0, 1, 0)>(vb), h1 = tr_read<v_rd_off(D0, 1, 1)>(vb);
  const s16x4 l2 = tr_read<v_rd_off(D0, 2, 0)>(vb), h2 = tr_read<v_rd_off(D0, 2, 1)>(vb), l3 = tr_read<v_rd_off(D0, 3, 0)>(vb), h3 = tr_read<v_rd_off(D0, 3, 1)>(vb);
  asm volatile("s_waitcnt lgkmcnt(0)" ::: "memory"); SBAR();
#define PK(L, H) (bf16x8){L[0], L[1], L[2], L[3], H[0], H[1], H[2], H[3]}
  od = __builtin_amdgcn_mfma_f32_32x32x16_bf16(pa0, PK(l0, h0), od, 0, 0, 0);
  od = __builtin_amdgcn_mfma_f32_32x32x16_bf16(pa1, PK(l1, h1), od, 0, 0, 0);
  od = __builtin_amdgcn_mfma_f32_32x32x16_bf16(pa2, PK(l2, h2), od, 0, 0, 0);
  od = __builtin_amdgcn_mfma_f32_32x32x16_bf16(pa3, PK(l3, h3), od, 0, 0, 0);
#undef PK
}
__device__ __forceinline__ void pv_d0(f32x16* o, int vb, bf16x8 pa0, bf16x8 pa1, bf16x8 pa2, bf16x8 pa3) {
  pv_one<0>(o[0], vb, pa0, pa1, pa2, pa3); pv_one<1>(o[1], vb, pa0, pa1, pa2, pa3); pv_one<2>(o[2], vb, pa0, pa1, pa2, pa3); pv_one<3>(o[3], vb, pa0, pa1, pa2, pa3);
}
__device__ __forceinline__ void unit(const bf16_t* __restrict__ Qb, const bf16_t* __restrict__ Kh, const bf16_t* __restrict__ Vh, bf16_t* __restrict__ Ob, int ldo, int seq,
                                     char* lds, float lam, const float* __restrict__ subg) {
  int tid = threadIdx.x; asm volatile("" : "+v"(tid));
  const int wid = __builtin_amdgcn_readfirstlane(tid >> 6), lane = tid & 63, r32 = lane & 31, hi = lane >> 5;
  const int comp = wid & 1, rg = wid >> 1, cofs = comp * 64;
  char* V_lds = lds; char* K_lds = lds + 2 * SHM_V;
  float* ws = (float*)(lds + WS_OFF) + wid * 64; float* li_l = ws; float* al_l = ws + 32;
  float m_reg = 0.f; f32x16 o[4] = {}; f32x16 ol = {}; bf16x8 qr[4];
  const bf16_t* Qw = Qb + (long)(rg * 32 + r32) * 1024 + cofs + hi * 8;
#pragma unroll
  for (int d0 = 0; d0 < 4; ++d0) qr[d0] = *reinterpret_cast<const bf16x8*>(Qw + d0 * 16);
  const int sr = tid >> 4, sc = (tid & 15) * 8, vst0 = v_st(sr, sc), vst1 = v_st(32 + sr, sc);
  const int vb0 = (int)(uintptr_t)V_lds + v_rd_base(lane);
  struct { bf16x8 vs0, vs1, ks0, ks1; } sr_[1];
#define LD8(p) (*reinterpret_cast<const bf16x8*>(p))
#define SLOAD(i, k0) do { sr_[i].vs0 = LD8(&Vh[(long)((k0) + sr) * LDK + sc]); sr_[i].vs1 = LD8(&Vh[(long)((k0) + 32 + sr) * LDK + sc]); \
    sr_[i].ks0 = LD8(&Kh[(long)((k0) + sr) * LDK + sc]); sr_[i].ks1 = LD8(&Kh[(long)((k0) + 32 + sr) * LDK + sc]); } while (0)
#define SWRITE(b, i) do { *(bf16x8*)(V_lds + (b) * SHM_V + vst0) = sr_[i].vs0;          \
    *(bf16x8*)(V_lds + (b) * SHM_V + vst1) = sr_[i].vs1; int kc = sc * 2;               \
    *(bf16x8*)(K_lds + (b) * SHM_K + KSWZ(sr, kc)) = sr_[i].ks0;                       \
    *(bf16x8*)(K_lds + (b) * SHM_K + KSWZ(32 + sr, kc)) = sr_[i].ks1; } while (0)
#define SWAIT() asm volatile("s_waitcnt vmcnt(4)" ::: "memory")
#define RESC(a) do { if (__any((a) < 1.f)) { if (hi == 0) al_l[r32] = (a); asm volatile("s_waitcnt lgkmcnt(0)" ::: "memory"); \
    _Pragma("unroll") for (int r = 0; r < 16; ++r) { const float f_ = al_l[crow(r, hi)]; ol[r] *= f_; _Pragma("unroll") for (int d = 0; d < 4; ++d) o[d][r] *= f_; } } } while (0)
  f32x16 pA0, pA1, pB0, pB1; float alA, alB; f32x16 negm = {}; asm volatile("" : "+v"(negm)); bf16x8 pa0, pa1, pa2, pa3; const int NT = seq / KVBLK;
  const LAS char* Kl = (const LAS char*)K_lds; const LAS char* Vl = (const LAS char*)V_lds + v_rd_base(lane);
  SLOAD(0, 0); asm volatile("s_waitcnt vmcnt(0)" ::: "memory"); SWRITE(0, 0); SLOAD(0, KVBLK); __syncthreads();
  qkt(pA0, pA1, K_lds, qr, r32, hi, cofs, negm); rowmaxSM<true>(pA0, pA1, m_reg, negm, alA);
#pragma unroll
  for (int r = 0; r < 16; ++r) { pA0[r] = __builtin_amdgcn_exp2f(pA0[r]); pA1[r] = __builtin_amdgcn_exp2f(pA1[r]); }
  asm volatile("s_waitcnt vmcnt(0)" ::: "memory"); SWRITE(1, 0); SLOAD(0, 2 * KVBLK); __syncthreads();
#pragma unroll 1
  for (int j = 1; j + 1 < NT; j += 2) {
    SBAR(); seg1(pB0, pB1, pA0, pA1, alA, pa0, pa1, pa2, pa3, Kl + SHM_K, qr, negm, r32, hi, cofs);
    rowmaxSM<false>(pB0, pB1, m_reg, negm, alB); SBAR();
    seg2<true>(o, ol, Vl, pa0, pa1, pa2, pa3, pB0, pB1);
    __syncthreads(); asm volatile("s_waitcnt vmcnt(0)" ::: "memory"); SWRITE(0, 0); SLOAD(0, (j + 2) * KVBLK);
    RESC(alB); __syncthreads();
    SBAR(); seg1(pA0, pA1, pB0, pB1, alB, pa0, pa1, pa2, pa3, Kl, qr, negm, r32, hi, cofs);
    rowmaxSM<false>(pA0, pA1, m_reg, negm, alA); SBAR();
    seg2<true>(o, ol, Vl + SHM_V, pa0, pa1, pa2, pa3, pA0, pA1);
    __syncthreads(); asm volatile("s_waitcnt vmcnt(0)" ::: "memory"); SWRITE(1, 0); if (j + 3 < NT) SLOAD(0, (j + 3) * KVBLK);
    RESC(alA); __syncthreads();
  }
  SBAR(); seg1(pB0, pB1, pA0, pA1, alA, pa0, pa1, pa2, pa3, Kl + SHM_K, qr, negm, r32, hi, cofs); SBAR();
  rowmaxSM<false>(pB0, pB1, m_reg, negm, alB); SBAR();
  seg2<true>(o, ol, Vl, pa0, pa1, pa2, pa3, pB0, pB1);
  __syncthreads(); RESC(alB);
  { float dl = 0.f; finishSM(pB0, pB1, alB, dl, pa0, pa1, pa2, pa3, false); } SBAR();
  seg2<false>(o, ol, Vl + SHM_V, pa0, pa1, pa2, pa3, pB0, pB1);
  float rli[16];
#pragma unroll
  for (int r = 0; r < 16; ++r) rli[r] = __builtin_amdgcn_rcpf(ol[r]);
  float* ex = (float*)(lds + EXCH_OFF) + rg * 4096;
  if (comp == 1) {
#pragma unroll
    for (int d0 = 0; d0 < 4; ++d0)
#pragma unroll
      for (int r = 0; r < 16; ++r) ex[(d0 * 16 + r) * 64 + lane] = o[d0][r] * rli[r] * lam;
  }
  float gv[4];
#pragma unroll
  for (int d0 = 0; d0 < 4; ++d0) gv[d0] = subg[d0 * 32 + r32] * (1.f - LAMBDA_INIT);
  __syncthreads();
  if (comp == 0) {
#pragma unroll
    for (int r = 0; r < 16; ++r)
#pragma unroll
      for (int d0 = 0; d0 < 4; ++d0) o[d0][r] = o[d0][r] * rli[r] - ex[(d0 * 16 + r) * 64 + lane];
    asm volatile("s_waitcnt lgkmcnt(0)" ::: "memory");
    char* stg = (char*)ex;
#pragma unroll
    for (int r = 0; r < 16; ++r) {
      float ss = 0.f;
#pragma unroll
      for (int d0 = 0; d0 < 4; ++d0) ss += o[d0][r] * o[d0][r];
#pragma unroll
      for (int s = 1; s < 32; s <<= 1) ss += __shfl_xor(ss, s);
      const float rs = rsqrtf(ss * (1.f / 128.f) + SUBLN_EPS);
      bf16_t* srow = (bf16_t*)(stg + crow(r, hi) * 272) + r32;
#pragma unroll
      for (int d0 = 0; d0 < 4; ++d0) srow[d0 * 32] = (bf16_t)(cvt_pk_bf16(o[d0][r] * rs * gv[d0], 0.f) & 0xffffu);
    }
    asm volatile("s_waitcnt lgkmcnt(0)" ::: "memory");
#pragma unroll
    for (int i = 0; i < 8; ++i) { const int row = i * 4 + (lane >> 4), ch = lane & 15;
      const u32x4 v = *(const u32x4*)(stg + row * 272 + ch * 16);
      *(u32x4*)(Ob + (long)(rg * 32 + row) * ldo + ch * 8) = v; }
  }
  __syncthreads();
#undef LD8
#undef SLOAD
#undef SWRITE
#undef SWAIT
#undef RESC
}
#undef SBAR
}

namespace lru {
constexpr int CH = 64, AST = 272;
constexpr int L_A = 0, L_XCF = 17408, L_G = L_XCF + 32768, L_PS = L_G + 65536;
struct Params { const bf16_t* xr; bf16_t* hf; const bf16_t* gyr; bf16_t* lo; const bf16_t* Wt; const float* conv_w; const float* conv_b; const float* ba; const float* bx; const float* aparam; };
__device__ __forceinline__ void unit(const Params& P, int uid, int Tseq, char* lds) {
  int tid = threadIdx.x; asm volatile("" : "+v"(tid));
  const int wid = __builtin_amdgcn_readfirstlane(tid >> 6), lane = tid & 63, r32 = lane & 31, hi = lane >> 5;
  const int nb = uid & 7, sq = uid >> 3;
  const long rowbase = (long)sq * Tseq; const int cb0 = nb * 128;
  const int cg8 = tid & 15, tgp = tid >> 4; const int cch = cb0 + cg8 * 8;
  const int gate = wid & 1, cgp = wid >> 1;
  const int c = tid & 127, sg = tid >> 7;
  const int nch = Tseq / CH;
  const bf16_t* xcol = P.xr + (size_t)rowbase * 1024 + cch;
  bf16_t* hfcol = P.hf + (size_t)rowbase * 1024 + cb0 + c;
  const bf16_t* gcol = P.gyr + (size_t)rowbase * 1024 + cb0 + c;
  bf16_t* locol = P.lo + (size_t)rowbase * 2048 + 1024 + cb0 + c;
  float* xcf = (float*)(lds + L_XCF); float* G = (float*)(lds + L_G); f32x2* PS = (f32x2*)(lds + L_PS);
  float* cwl = (float*)(lds + L_PS + 4096);
  if (tid < 160) { const int j = tid >> 5, c4 = (tid & 31) * 4; const float* srcp = j < 4 ? P.conv_w + j * 1024 + cb0 + c4 : P.conv_b + cb0 + c4; *(f32x4*)(cwl + j * 128 + c4) = *(const f32x4*)srcp; }
  __syncthreads();
#pragma unroll 1
  for (int dir = 0; dir < 2; ++dir) {
    const float gbias = (gate == 0 ? P.ba : P.bx)[dir * 1024 + cb0 + cgp * 32 + r32];
    float sp; { const float z = -P.aparam[dir * 1024 + cb0 + c]; sp = fmaxf(z, 0.f) + log1pf(__expf(-fabsf(z))); }
    const float spl = -8.f * 1.4426950408889634f * sp;
    float carry = 0.f;
    bf16x8 xin[5];
#define LRU_LOAD(cc) do { const int tb = (cc) * CH + 2 * tgp - 2; _Pragma("unroll") for (int i = 0; i < 5; ++i) { const int t = tb + i; \
      xin[i] = (t >= 0 && t < Tseq) ? *(const bf16x8*)(xcol + (size_t)t * 1024) : (bf16x8){0, 0, 0, 0, 0, 0, 0, 0}; } } while (0)
    LRU_LOAD(dir ? nch - 1 : 0);
#pragma unroll 1
    for (int ci = 0; ci < nch; ++ci) {
      const int cc = dir ? nch - 1 - ci : ci, t0 = cc * CH;
      bf16x8 bfr[8];
      { const bf16_t* wt = P.Wt; asm volatile("" : "+s"(wt));
        const GAS bf16_t* wp = (const GAS bf16_t*)(wt + ((size_t)((dir * 2 + gate) * 8 + nb)) * 16384 + (size_t)(cgp * 32 + r32) * 128 + hi * 8);
#pragma unroll
        for (int ks = 0; ks < 8; ++ks) bfr[ks] = *(const GAS bf16x8*)(wp + ks * 16); }
      { float cw[4][8], cbias[8];
        {
#pragma unroll
          for (int j = 0; j < 4; ++j) { const f32x4 a = *(const f32x4*)(cwl + j * 128 + cg8 * 8), b = *(const f32x4*)(cwl + j * 128 + cg8 * 8 + 4);
#pragma unroll
            for (int e = 0; e < 4; ++e) { cw[j][e] = a[e]; cw[j][4 + e] = b[e]; } }
          const f32x4 a = *(const f32x4*)(cwl + 512 + cg8 * 8), b = *(const f32x4*)(cwl + 512 + cg8 * 8 + 4);
#pragma unroll
          for (int e = 0; e < 4; ++e) { cbias[e] = a[e]; cbias[4 + e] = b[e]; } }
        float xf[5][8];
#pragma unroll
        for (int i = 0; i < 5; ++i)
#pragma unroll
          for (int e = 0; e < 8; ++e) xf[i][e] = bf2f((unsigned short)xin[i][e]);
#pragma unroll
        for (int i = 0; i < 2; ++i) {
          float xc[8];
#pragma unroll
          for (int e = 0; e < 8; ++e) xc[e] = cbias[e] + cw[0][e] * xf[i][e] + cw[1][e] * xf[i + 1][e] + cw[2][e] * xf[i + 2][e] + cw[3][e] * xf[i + 3][e];
          u32x4 w; w.x = cvt_pk_bf16(xc[0], xc[1]); w.y = cvt_pk_bf16(xc[2], xc[3]); w.z = cvt_pk_bf16(xc[4], xc[5]); w.w = cvt_pk_bf16(xc[6], xc[7]);
          *(u32x4*)(lds + L_A + (2 * tgp + i) * AST + cg8 * 16) = w;
          float* xp = xcf + (2 * tgp + i) * 128 + cg8 * 8; *(f32x4*)xp = (f32x4){xc[0], xc[1], xc[2], xc[3]}; *(f32x4*)(xp + 4) = (f32x4){xc[4], xc[5], xc[6], xc[7]};
        } }
      if (ci + 1 < nch) LRU_LOAD(dir ? nch - 2 - ci : ci + 1);
      __syncthreads();
#pragma unroll
      for (int tg = 0; tg < 2; ++tg) { f32x16 acc = {};
#pragma unroll
        for (int ks = 0; ks < 8; ++ks) { const bf16x8 a = *(const bf16x8*)(lds + L_A + (tg * 32 + r32) * AST + ks * 32 + hi * 16);
          acc = __builtin_amdgcn_mfma_f32_32x32x16_bf16(a, bfr[ks], acc, 0, 0, 0); }
#pragma unroll
        for (int r = 0; r < 16; ++r) { const int tok = tg * 32 + dattn::crow(r, hi); G[(gate * CH + tok) * 128 + cgp * 32 + r32] = sigmoidf_(acc[r] + gbias); } }
      __syncthreads();
      unsigned short hfv[16], gyv[16];
      if (dir) { const GAS bf16_t* hp = (const GAS bf16_t*)(hfcol + (size_t)(t0 + CH - 1 - sg * 16) * 1024); const GAS bf16_t* gp = (const GAS bf16_t*)(gcol + (size_t)(t0 + CH - 1 - sg * 16) * 1024);
#pragma unroll
        for (int k = 0; k < 16; ++k) { hfv[k] = *hp; gyv[k] = *gp; hp -= 1024; gp -= 1024; asm volatile("" : "+v"(hp), "+v"(gp)); } }
      float av[16], uv[16]; float Pp = 1.f, Ss = 0.f;
#pragma unroll
      for (int k = 0; k < 16; ++k) { const int p = sg * 16 + k, tl = dir ? CH - 1 - p : p;
        const float r_ = G[tl * 128 + c], i_ = G[(CH + tl) * 128 + c], x_ = xcf[tl * 128 + c];
        const float a = __builtin_amdgcn_exp2f(spl * r_); float mult = __builtin_amdgcn_sqrtf(fmaxf(1.f - a * a, 0.f));
        if (ci == 0 && p == 0) mult = 1.f;
        const float u = mult * i_ * x_; av[k] = a; uv[k] = u; Ss = a * Ss + u; Pp *= a; }
      PS[sg * 128 + c] = (f32x2){Pp, Ss};
      __syncthreads();
      float h = carry, hin = 0.f;
#pragma unroll
      for (int s2 = 0; s2 < 4; ++s2) { const f32x2 ps = PS[s2 * 128 + c]; if (s2 == sg) hin = h; h = ps[0] * h + ps[1]; }
      carry = h; h = hin;
      if (dir == 0) { GAS bf16_t* hp = (GAS bf16_t*)(hfcol + (size_t)(t0 + sg * 16) * 1024);
#pragma unroll
        for (int k = 0; k < 16; ++k) { h = av[k] * h + uv[k]; *hp = (bf16_t)(cvt_pk_bf16(h, 0.f) & 0xffffu); hp += 1024; asm volatile("" : "+v"(hp)); }
      } else { GAS bf16_t* lp = (GAS bf16_t*)(locol + (size_t)(t0 + CH - 1 - sg * 16) * 2048);
#pragma unroll
        for (int k = 0; k < 16; ++k) { h = av[k] * h + uv[k];
          *lp = (bf16_t)(cvt_pk_bf16((h + bf2f(hfv[k])) * bf2f(gyv[k]), 0.f) & 0xffffu); lp -= 2048; asm volatile("" : "+v"(lp)); }
      }
    }
    asm volatile("s_waitcnt vmcnt(0)" ::: "memory");
    __syncthreads();
#undef LRU_LOAD
  }
}
}

__device__ __forceinline__ unsigned pk2(float lo, float hi) { return cvt_pk_bf16(lo, hi); }
__device__ __forceinline__ void transpose_item(const float* W, int K, int N, bf16_t* WT, int k0, int n0, int drow0, LAS float* scr, int lane, int ldk = 0, int koff = 0) {
    if (ldk == 0) ldk = K;
#pragma unroll 8
    for (int i = 0; i < 32; ++i) { const int kk = 2 * i + (lane >> 5); scr[kk * 33 + (lane & 31)] = W[(size_t)(k0 + kk) * N + n0 + (lane & 31)]; }
    asm volatile("s_waitcnt lgkmcnt(0)" ::: "memory");
    const int c = lane & 7;
#pragma unroll
    for (int j = 0; j < 4; ++j) { const int n = (lane >> 3) + 8 * j; const LAS float* s = scr + (8 * c) * 33 + n;
        u32x4 o; o.x = pk2(s[0 * 33], s[1 * 33]); o.y = pk2(s[2 * 33], s[3 * 33]); o.z = pk2(s[4 * 33], s[5 * 33]); o.w = pk2(s[6 * 33], s[7 * 33]);
        *(u32x4*)(WT + (size_t)(drow0 + n) * ldk + koff + k0 + 8 * c) = o; }
    asm volatile("s_waitcnt lgkmcnt(0)" ::: "memory");
}
__device__ __forceinline__ int ffin_row(int n) { return n < DFF ? (n >> 7) * 256 + (n & 127) : ((n - DFF) >> 7) * 256 + 128 + ((n - DFF) & 127); }
__device__ __forceinline__ void cvt_rows(const float* src, bf16_t* dst, size_t n8, size_t gtid, size_t gthreads) {
    for (size_t i = gtid; i < n8; i += gthreads) { const f32x4 a = *(const f32x4*)(src + i * 8), b = *(const f32x4*)(src + i * 8 + 4);
        u32x4 w; w.x = pk2(a[0], a[1]); w.y = pk2(a[2], a[3]); w.z = pk2(b[0], b[1]); w.w = pk2(b[2], b[3]); *(u32x4*)(dst + i * 8) = w; }
}
__device__ __forceinline__ void ln_row(const float* yrow, const float* g, const float* b, float* of, bf16_t* ob, int lane) {
    f32x4 v[4]; float s = 0.f;
#pragma unroll
    for (int j = 0; j < 4; ++j) { v[j] = *(const f32x4*)(yrow + 256 * j + 4 * lane); s += (v[j][0] + v[j][1]) + (v[j][2] + v[j][3]); }
    const float mean = wave_sum(s) * (1.f / 1024.f); float s2 = 0.f;
#pragma unroll
    for (int j = 0; j < 4; ++j) { v[j] = v[j] - mean; s2 += (v[j][0] * v[j][0] + v[j][1] * v[j][1]) + (v[j][2] * v[j][2] + v[j][3] * v[j][3]); }
    const float rstd = rsqrtf(wave_sum(s2) * (1.f / 1024.f) + LN_EPS);
#pragma unroll
    for (int j = 0; j < 4; ++j) { const f32x4 gg = *(const f32x4*)(g + 256 * j + 4 * lane), bb = *(const f32x4*)(b + 256 * j + 4 * lane);
        const f32x4 o = v[j] * rstd * gg + bb; *(f32x4*)(of + 256 * j + 4 * lane) = o;
        if (ob) { u32x2 w; w.x = pk2(o[0], o[1]); w.y = pk2(o[2], o[3]); *(u32x2*)(ob + 256 * j + 4 * lane) = w; } }
}


#define XB_TMO      128
#define XB_XCNT(j)  (256  + 64 * (j))
#define XB_XSUB(j)  (1280 + 64 * (j))
#define XB_XGEN(j)  (2304 + 64 * (j))
#define XB_TOP      3328
#define XB_TOPGEN   3392
#define XCD_BAR_WORDS 3456
#define XB_SPIN_CAP (1u << 20)
__device__ __forceinline__ unsigned xb_ld(unsigned* p)              { return __hip_atomic_load(p, __ATOMIC_RELAXED, __HIP_MEMORY_SCOPE_AGENT); }
__device__ __forceinline__ unsigned xb_add(unsigned* p, unsigned v) { return __hip_atomic_fetch_add(p, v, __ATOMIC_RELAXED, __HIP_MEMORY_SCOPE_AGENT); }
__device__ __forceinline__ unsigned xb_xcc_id() { return (unsigned)__builtin_amdgcn_s_getreg((3 << 11) | 20) & 0xFu; }
#define XB_SPIN(cond, bar) do { unsigned _sp = 0; while (cond) { __builtin_amdgcn_s_sleep(1); \
    if ((++_sp & 255u) == 0u) { if (xb_ld(&(bar)[XB_TMO])) break; if (_sp > XB_SPIN_CAP) { atomicAdd(&(bar)[XB_TMO], 1u); break; } } } } while (0)
struct XcdBarrier { unsigned* bar; unsigned x; volatile LAS unsigned* st; };
__device__ __forceinline__ XcdBarrier xcd_barrier_post(unsigned* bar, volatile LAS unsigned* st) {
    XcdBarrier b; b.bar = bar; b.x = xb_xcc_id(); b.st = st;
    if (threadIdx.x == 0) (void)xb_add(&bar[XB_XCNT(b.x)], 1u);
    return b;
}
__device__ __forceinline__ void xcd_barrier_complete(unsigned* bar, unsigned x, unsigned& nloc, unsigned& nx) {
    const unsigned G = gridDim.x * gridDim.y * gridDim.z;
    unsigned sum, cnt, mine, sp = 0u;
    for (;;) {
        sum = 0u; cnt = 0u; mine = 0u;
#pragma unroll
        for (unsigned j = 0; j < 16; ++j) { const unsigned c = xb_ld(&bar[XB_XCNT(j)]); sum += c; cnt += (c > 0u) ? 1u : 0u; mine = (j == x) ? c : mine; }
        if (sum == G) break;
        __builtin_amdgcn_s_sleep(1);
        if ((++sp & 255u) == 0u) { if (xb_ld(&bar[XB_TMO])) break; if (sp > XB_SPIN_CAP) { atomicAdd(&bar[XB_TMO], 1u); break; } }
    }
    nloc = mine > 0u ? mine : 1u; nx = cnt > 0u ? cnt : 1u;
}
__device__ __forceinline__ void xcd_barrier(const XcdBarrier& b) {
    asm volatile("s_waitcnt vmcnt(0)" ::: "memory");
    __syncthreads();
    if (threadIdx.x == 0) {
        unsigned* bar = b.bar;
        __builtin_amdgcn_s_waitcnt(0);
        unsigned nloc = b.st[0], nx = b.st[1];
        if (nloc == 0u) { xcd_barrier_complete(bar, b.x, nloc, nx); b.st[0] = nloc; b.st[1] = nx; }
        const unsigned old = xb_add(&bar[XB_XSUB(b.x)], 1u);
        const unsigned gen = old / nloc;
        if (old + 1u == (gen + 1u) * nloc) {
            __builtin_amdgcn_fence(__ATOMIC_RELEASE, "agent");
            asm volatile("s_waitcnt vmcnt(0)" ::: "memory");
            const unsigned og = xb_add(&bar[XB_TOP], 1u);
            const unsigned tg = og / nx;
            if (og + 1u == (tg + 1u) * nx) xb_add(&bar[XB_TOPGEN], 1u);
            else XB_SPIN(xb_ld(&bar[XB_TOPGEN]) == tg, bar);
            __builtin_amdgcn_fence(__ATOMIC_ACQUIRE, "agent");
            xb_add(&bar[XB_XGEN(b.x)], 1u);
            asm volatile("s_waitcnt vmcnt(0)" ::: "memory");
        } else {
            XB_SPIN(xb_ld(&bar[XB_XGEN(b.x)]) == gen, bar);
            __builtin_amdgcn_fence(__ATOMIC_ACQUIRE, "agent");
            asm volatile("s_waitcnt vmcnt(0)" ::: "memory");
        }
    }
    __syncthreads();
}

constexpr size_t WS_PTRS = 8192;
__device__ __forceinline__ const float* inptr(const unsigned char* ws, int i) {
    const GAS unsigned* p = (const GAS unsigned*)(ws + WS_PTRS) + 2 * i;
    const unsigned lo = __builtin_amdgcn_readfirstlane(p[0]), hi = __builtin_amdgcn_readfirstlane(p[1]);
    return (const float*)(const GAS float*)(((unsigned long long)hi << 32) | lo);
}
#ifndef PH_MASK
#define PH_MASK 0xffffffffu
#endif
#define PHON(k) ((PH_MASK >> (k)) & 1u)
#ifndef REP_MASK
#define REP_MASK 0u
#endif
#define NREP(k) (1 + (int)((REP_MASK >> (k)) & 1u))
struct Args { const float* in[31]; float* out; unsigned char* ws; int ph_lo, ph_hi; };
enum { I_XP = 0, I_XS, I_MP, I_MS, I_WIN, I_LQ1, I_LK1, I_LQ2, I_LK2, I_SUBG, I_CONVW, I_CONVB, I_LWA, I_LBA, I_LWX, I_LBX, I_LA, I_PATTN, I_PLRU, I_WMIX,
       I_LN1G, I_LN1B, I_XAQ, I_XAKV, I_XAO, I_LN2G, I_LN2B, I_FFIN, I_FFOUT, I_LN3G, I_LN3B };

__global__ void __launch_bounds__(NTHREADS, 2) mk_fwd(Args args) {
    extern __shared__ __attribute__((aligned(16))) unsigned char lds_raw[];
    cg::grid_group grid = cg::this_grid();
    int phase = 0;
    volatile LAS unsigned* bst = (volatile LAS unsigned*)((LAS unsigned char*)lds_raw + LDS_BYTES - 128);
    if (threadIdx.x < 2) bst[threadIdx.x] = 0u;
    __syncthreads();
    const XcdBarrier xbar = xcd_barrier_post((unsigned*)(args.ws + WS_CTL) + CW_BAR, bst);
#define SEAM() do { ++phase; if (phase > args.ph_lo && phase < args.ph_hi) { if (args.ph_lo < 0) grid.sync(); else xcd_barrier(xbar); } } while (0)
#define ACTIVE() (phase >= args.ph_lo && phase < args.ph_hi)
#define FRESH() LAS unsigned char* lds = (LAS unsigned char*)lds_raw; int tid = threadIdx.x; asm volatile("" : "+v"(tid)); \
    const int lane = tid & 63, wave = __builtin_amdgcn_readfirstlane(tid >> 6); GAS unsigned char* wsg_ = (GAS unsigned char*)args.ws; asm volatile("" : "+s"(wsg_)); unsigned char* ws = (unsigned char*)wsg_; \
    const int G = gridDim.x, bx = blockIdx.x; const size_t gtid = (size_t)bx * NTHREADS + tid, gthreads = (size_t)G * NTHREADS; const int gw = bx * NWAVES + wave, NGW = G * NWAVES; \
    (void)lds; (void)lane; (void)wave; (void)gtid; (void)gthreads; (void)gw; (void)NGW;
#define WSP(T, off) ((T*)(ws + (off)))
#define INP(i) inptr(ws, (i))

    if (ACTIVE() && PHON(0)) {
        FRESH();
        unsigned* ctl = WSP(unsigned, WS_CTL); float* rope = WSP(float, WS_ROPE);
        if (bx == 0 && tid < 256) ctl[CW_QUEUE + tid] = 0u;
        if (gtid == 0) { const float** tbl = WSP(const float*, WS_PTRS);
#pragma unroll
            for (int i = 0; i < 31; ++i) tbl[i] = args.in[i]; }
        if (bx == 0 && wave == 1) {
            const float a = wave_sum(args.in[I_LQ1][lane] * args.in[I_LK1][lane]), b = wave_sum(args.in[I_LQ2][lane] * args.in[I_LK2][lane]);
            if (lane == 0) ((float*)ctl)[CW_LAM] = __expf(a) - __expf(b) + LAMBDA_INIT;
        }
        for (size_t i = gtid; i < 8192 * 8; i += gthreads) { const int t = (int)(i >> 3), j = (int)(i & 7);
            const float inv = exp2f(-(float)j * 0.125f * 18.931568569324174f);
            const float ang = (float)t * inv; const double rev = (double)ang * 0.15915494309189535; const float fr = (float)(rev - floor(rev));
            rope[t * 16 + j] = __builtin_amdgcn_cosf(fr); rope[t * 16 + 8 + j] = __builtin_amdgcn_sinf(fr); }
        LAS float* scr = (LAS float*)(lds + wave * 16384);
        int it0 = gw;
#pragma unroll 1
        for (int jb = 0; jb < 9; ++jb) {
            const float* W; int K = 1024, N = 1024; bf16_t* WT; int kind = 0, ldk = 0, koff = 0;
            switch (jb) {
                case 0: W = args.in[I_WIN]; N = INW; WT = WSP(bf16_t, WS_WIN); break;
                case 1: W = args.in[I_PATTN]; WT = WSP(bf16_t, WS_PATTN); ldk = 2048; break;
                case 2: W = args.in[I_PLRU]; WT = WSP(bf16_t, WS_PATTN); ldk = 2048; koff = 1024; break;
                case 3: W = args.in[I_WMIX]; WT = WSP(bf16_t, WS_WMIX); break;
                case 4: W = args.in[I_XAQ]; WT = WSP(bf16_t, WS_XAQ); break;
                case 5: W = args.in[I_XAO]; WT = WSP(bf16_t, WS_XAO); break;
                case 6: W = args.in[I_XAKV]; N = 2048; WT = WSP(bf16_t, WS_XAKV); break;
                case 7: W = args.in[I_FFIN]; N = 2 * DFF; WT = WSP(bf16_t, WS_FFIN); kind = 1; break;
                default: W = args.in[I_FFOUT]; K = DFF; WT = WSP(bf16_t, WS_FFOUT); break;
            }
            const int nblk = N / 32, nit = (K / 64) * nblk;
#pragma unroll 1
            for (; it0 < nit; it0 += NGW) { const int kb = it0 / nblk, nbk = it0 % nblk, n0 = 32 * nbk;
                transpose_item(W, K, N, WT, 64 * kb, n0, kind ? ffin_row(n0) : n0, scr, lane, ldk, koff); }
            it0 -= nit; }
#pragma unroll 1
        for (int it = gw; it < 32 * 8; it += NGW) { const int mat = it >> 3, sub = it & 7, kb = sub >> 2, nbk = sub & 3;
            const int dir = mat >> 4, gate = (mat >> 3) & 1, nb = mat & 7;
            const float* src = (gate == 0 ? args.in[I_LWA] : args.in[I_LWX]) + (size_t)(dir * 8 + nb) * 16384;
            transpose_item(src, 128, 128, WSP(bf16_t, WS_LRUW) + (size_t)mat * 16384, 64 * kb, 32 * nbk, 32 * nbk, scr, lane); }
        cvt_rows(args.in[I_XP], WSP(bf16_t, WS_XB), (size_t)RM * 1024 / 8, gtid, gthreads);
        cvt_rows(args.in[I_XS], WSP(bf16_t, WS_XB) + (size_t)RM * 1024, (size_t)2 * RM * 1024 / 8, gtid, gthreads);
        cvt_rows(args.in[I_MP], WSP(bf16_t, WS_MEMB), (size_t)1024 * 1024 / 8, gtid, gthreads);
        cvt_rows(args.in[I_MS], WSP(bf16_t, WS_MEMB) + (size_t)1024 * 1024, (size_t)8192 * 1024 / 8, gtid, gthreads);
    }
    SEAM();

#pragma unroll 1
    for (int r = 0; r < NROUND; ++r) {
        const int Tseq = r == 0 ? 8192 : 2048, nseq = RM / Tseq, seq0 = r == 0 ? 0 : 4 + (r - 1) * 16, tsh = r == 0 ? 5 : 3;
#define XIN() (r == 0 ? INP(I_XP) : INP(I_XS) + (size_t)(r - 1) * RM * 1024)
#define OUTR() (args.out + (size_t)r * RM * 1024)

        if (ACTIVE() && PHON(1)) {
            FRESH();
            for (int rep = 0; rep < NREP(1); ++rep)
            { pg8::Gemm g{WSP(bf16_t, WS_XB) + (size_t)r * RM * 1024, WSP(bf16_t, WS_WIN), 1024, 1024, 1024}; pg8::StaticOrder S; S.init(RM, INW, G, bx);
              pg8::EpiProj E{WSP(bf16_t, WS_Q), WSP(float, WS_ROPE), Tseq - 1}; pg8::gemm_phase(lds, g, S, E); }
            if (r == 0) { pg8::Gemm g{WSP(bf16_t, WS_MEMB), WSP(bf16_t, WS_XAKV), 1024, 1024, 1024}; pg8::StaticOrder S; S.init(NMEMROW, 2048, G, bx);
              pg8::EpiKV E{WSP(bf16_t, WS_KX), WSP(bf16_t, WS_VXT)}; pg8::gemm_phase(lds, g, S, E); }
        }
        SEAM();
        if (ACTIVE() && PHON(2)) {
            FRESH();
            unsigned* ctl = WSP(unsigned, WS_CTL);
            const int nlru = nseq * 8, qpb = Tseq / 128, natt = nseq * 8 * qpb;
            LAS int* qslot = (LAS int*)(lds + LDS_BYTES - 64);
            if (PHON(16)) {
                const lru::Params LP{WSP(bf16_t, WS_XR), (bf16_t*)OUTR(), WSP(bf16_t, WS_GYR), WSP(bf16_t, WS_AOLO), WSP(bf16_t, WS_LRUW), INP(I_CONVW), INP(I_CONVB), INP(I_LBA), INP(I_LBX), INP(I_LA)};
                for (int rep = 0; rep < NREP(16); ++rep) for (;;) {
                    if (tid == 0) *qslot = (int)atomicAdd(ctl + CW_QUEUE + 64 * r + 8 * rep, 1u);
                    __syncthreads();
                    const int u = __builtin_amdgcn_readfirstlane(*qslot);
                    __syncthreads();
                    if (u >= nlru) break;
                    lru::unit(LP, u, Tseq, (char*)lds_raw);
                }
            }
            if (PHON(17)) {
                const float lam = ((const float*)ctl)[CW_LAM];
                const bf16_t* qb = WSP(bf16_t, WS_Q); const bf16_t* kb_ = WSP(bf16_t, WS_K); const bf16_t* vb = WSP(bf16_t, WS_V); bf16_t* aolo = WSP(bf16_t, WS_AOLO);
                for (int rep = 0; rep < NREP(17); ++rep) for (;;) {
                    if (tid == 0) *qslot = (int)atomicAdd(ctl + CW_QUEUE + 64 * r + 32 + 8 * rep, 1u);
                    __syncthreads();
                    const int a = __builtin_amdgcn_readfirstlane(*qslot);
                    __syncthreads();
                    if (a >= natt) break;
                    const int qi = a % qpb, hh = (a / qpb) & 7, sq = a / (qpb * 8);
                    const size_t row0 = (size_t)sq * Tseq;
                    dattn::unit(qb + (row0 + (size_t)qi * 128) * 1024 + hh * 128, kb_ + row0 * 1024 + hh * 128, vb + row0 * 1024 + hh * 128,
                                aolo + (row0 + (size_t)qi * 128) * 2048 + hh * 128, 2048, Tseq, (char*)lds_raw, lam, INP(I_SUBG));
                }
            }
        }
        SEAM();
        if (ACTIVE() && PHON(4)) for (int rep = 0; rep < NREP(4); ++rep) {
            FRESH();
            pg8::Gemm g{WSP(bf16_t, WS_AOLO), WSP(bf16_t, WS_PATTN), 2048, 2048, 2048}; pg8::StaticOrder S; S.init(RM, 1024, G, bx);
            pg8::EpiGateCat E{WSP(bf16_t, WS_SA), WSP(bf16_t, WS_SL), WSP(bf16_t, WS_MERGED)}; pg8::gemm_phase<true>(lds, g, S, E);
        }
        SEAM();
        if (ACTIVE() && PHON(5)) { FRESH(); pg8::Gemm g{WSP(bf16_t, WS_MERGED), WSP(bf16_t, WS_WMIX), 1024, 1024, 1024}; pg8::StaticOrder S; S.init(RM, 1024, G, bx);
            pg8::EpiResidLN<true> E{XIN(), WSP(float, WS_Y), WSP(bf16_t, WS_X1B), INP(I_LN1G), INP(I_LN1B), {WSP(unsigned long long, WS_LNX), WSP(unsigned, WS_CTL) + CW_LNCNT + ((r * 3 + 0) * 128) * 16}, lds + XLDS_OFF};
            pg8::gemm_phase(lds, g, S, E); }
        SEAM();
        if (ACTIVE() && PHON(7)) { FRESH();
            { pg8::Gemm g{WSP(bf16_t, WS_X1B), WSP(bf16_t, WS_XAQ), 1024, 1024, 1024}; pg8::PmPnOrder S{(RM / 256) * 4, G, bx}; pg8::EpiBf16 E{WSP(bf16_t, WS_QX), 1024, 0.0625f}; pg8::gemm_phase(lds, g, S, E); }
            { pg8::Gemm g{WSP(bf16_t, WS_QX), WSP(bf16_t, WS_KX), 1024, 1024, 256}; pg8::XaOrder<0> S{(RM / 256) * 4, G, bx, tsh, seq0};
              pg8::EpiSoftmax E{WSP(bf16_t, WS_P), (LAS float*)(lds + XLDS_OFF)}; pg8::gemm_phase(lds, g, S, E); }
            { pg8::Gemm g{WSP(bf16_t, WS_P), WSP(bf16_t, WS_VXT), 1024, 256, 256}; pg8::XaOrder<1> S{(RM / 256) * 4, G, bx, tsh, seq0};
              pg8::EpiBf16 E{WSP(bf16_t, WS_OXA), 1024, 1.f}; pg8::gemm_phase(lds, g, S, E); }
        }
        SEAM();
        if (ACTIVE() && PHON(10)) { FRESH(); pg8::Gemm g{WSP(bf16_t, WS_OXA), WSP(bf16_t, WS_XAO), 1024, 1024, 1024}; pg8::StaticOrder S; S.init(RM, 1024, G, bx);
            pg8::EpiResidLN<true> E{WSP(float, WS_Y), WSP(float, WS_Y), WSP(bf16_t, WS_X2B), INP(I_LN2G), INP(I_LN2B), {WSP(unsigned long long, WS_LNX), WSP(unsigned, WS_CTL) + CW_LNCNT + ((r * 3 + 1) * 128) * 16}, lds + XLDS_OFF};
            pg8::gemm_phase(lds, g, S, E); }
        SEAM();
        if (ACTIVE() && PHON(12)) for (int rep = 0; rep < NREP(12); ++rep) { FRESH(); pg8::Gemm g{WSP(bf16_t, WS_X2B), WSP(bf16_t, WS_FFIN), 1024, 1024, 1024}; pg8::StaticOrder S; S.init(RM, 2 * DFF, G, bx); pg8::EpiSwiglu E{WSP(bf16_t, WS_HFF)}; pg8::gemm_phase(lds, g, S, E); }
        SEAM();
        if (ACTIVE() && PHON(13)) { FRESH(); pg8::Gemm g{WSP(bf16_t, WS_HFF), WSP(bf16_t, WS_FFOUT), DFF, DFF, DFF}; pg8::StaticOrder S; S.init(RM, 1024, G, bx);
            pg8::EpiResidLN<false> E{WSP(float, WS_Y), OUTR(), nullptr, INP(I_LN3G), INP(I_LN3B), {WSP(unsigned long long, WS_LNX), WSP(unsigned, WS_CTL) + CW_LNCNT + ((r * 3 + 2) * 128) * 16}, lds + XLDS_OFF};
            pg8::gemm_phase(lds, g, S, E); }
        SEAM();
    }
#undef SEAM
#undef ACTIVE
}

extern "C" void kernel_launch(void* const* d_in, const int* in_sizes, int n_in, void* d_out, int out_size, void* d_ws, size_t ws_size, hipStream_t stream) {
    static int grid = 0;
    if (grid == 0) {
        if (n_in != 31 || out_size != NTOK * 1024 || ws_size < WS_END) { fprintf(stderr, "kernel_launch: unexpected shapes n_in %d out %d ws %zu\n", n_in, out_size, ws_size); grid = -1; return; }
        int dev = 0, cus = 0, per_cu = 0;
        hipGetDevice(&dev); hipDeviceGetAttribute(&cus, hipDeviceAttributeMultiprocessorCount, dev);
        if (hipFuncSetAttribute((const void*)mk_fwd, hipFuncAttributeMaxDynamicSharedMemorySize, LDS_BYTES) != hipSuccess) { fprintf(stderr, "kernel_launch: hipFuncSetAttribute failed\n"); grid = -1; return; }
        hipOccupancyMaxActiveBlocksPerMultiprocessor(&per_cu, (const void*)mk_fwd, NTHREADS, LDS_BYTES);
        (void)hipGetLastError();
        if (per_cu < 1) per_cu = 1;
        grid = cus * 1;
        fprintf(stderr, "kernel_launch: cus %d per_cu %d grid %d\n", cus, per_cu, grid);
    }
    if (grid < 0) return;
    if (hipMemsetAsync((char*)d_ws + WS_CTL, 0, CTL_ZERO_BYTES, stream) != hipSuccess) { fprintf(stderr, "kernel_launch: memset failed\n"); return; }
    Args a{};
    for (int i = 0; i < 31; ++i) a.in[i] = (const float*)d_in[i];
    a.out = (float*)d_out; a.ws = (unsigned char*)d_ws; a.ph_lo = 0; a.ph_hi = 1000;
    void* kargs[] = {&a};
    hipError_t e = hipLaunchCooperativeKernel((const void*)mk_fwd, dim3(grid), dim3(NTHREADS), kargs, LDS_BYTES, stream);
    if (e != hipSuccess) fprintf(stderr, "kernel_launch: cooperative launch failed: %s (grid %d)\n", hipGetErrorString(e), grid);
}
```

```cpp
#include <hip/hip_runtime.h>
#include <hip/hip_cooperative_groups.h>
#include <cstdio>
#include <cstdint>
namespace cg = cooperative_groups;

#define LAS __attribute__((address_space(3)))
#define GAS __attribute__((address_space(1)))
typedef unsigned short bf16_t;
typedef short bf16x8 __attribute__((ext_vector_type(8)));
typedef short s16x4 __attribute__((ext_vector_type(4)));
typedef float f32x4 __attribute__((ext_vector_type(4)));
typedef float f32x2 __attribute__((ext_vector_type(2)));
typedef float f32x16 __attribute__((ext_vector_type(16)));
typedef unsigned u32x4 __attribute__((ext_vector_type(4)));
typedef unsigned u32x2 __attribute__((ext_vector_type(2)));

constexpr int DM = 1024, NTOK = 98304, RM = 32768, NROUND = 3, NMEMROW = 9216, DFF = 2816, INW = 7168;
constexpr float ALPHA = 1.189207115002721f;
constexpr float LN_EPS = 1e-5f, SUBLN_EPS = 1e-5f, LAMBDA_INIT = 0.2f;
constexpr int NWAVES = 8, NTHREADS = 512;
constexpr int LDS_BYTES = 147456, RING_BYTES = 131072, XLDS_OFF = RING_BYTES;

constexpr size_t MiB = 1u << 20;
constexpr size_t WS_CTL = 0, WS_ROPE = 1 * MiB;
constexpr size_t WS_WIN = 2 * MiB, WS_PATTN = 16 * MiB, WS_PLRU = 18 * MiB, WS_WMIX = 20 * MiB, WS_XAQ = 22 * MiB, WS_XAO = 24 * MiB, WS_XAKV = 26 * MiB;
constexpr size_t WS_FFIN = 30 * MiB, WS_FFOUT = 41 * MiB, WS_LRUW = 47 * MiB, WS_MEMB = 48 * MiB, WS_KX = 66 * MiB, WS_VXT = 84 * MiB, WS_XB = 104 * MiB;
constexpr size_t WS_Q = 296 * MiB, WS_K = 360 * MiB, WS_V = 424 * MiB, WS_XR = 488 * MiB, WS_GYR = 552 * MiB, WS_SA = 616 * MiB, WS_SL = 680 * MiB, WS_AOLO = 744 * MiB;
constexpr size_t SEG_STRIDE = 64 * MiB / 2;
constexpr size_t WS_MERGED = 296 * MiB, WS_TMP = 360 * MiB, WS_Y = 488 * MiB, WS_X1B = 872 * MiB, WS_QX = 936 * MiB, WS_P = 616 * MiB, WS_OXA = 680 * MiB;
constexpr size_t WS_X2B = 296 * MiB, WS_HFF = 744 * MiB, WS_LNX = 1000 * MiB, WS_END = 1002 * MiB;
constexpr int CW_QUEUE = 64;
constexpr int CW_LAM = 16;
constexpr int CW_BAR = 4096;
constexpr size_t CTL_ZERO_BYTES = 131072;
constexpr int CW_LNCNT = 8192;

__device__ __forceinline__ unsigned cvt_pk_bf16(float lo, float hi) { unsigned r; asm volatile("v_cvt_pk_bf16_f32 %0, %1, %2" : "=v"(r) : "v"(lo), "v"(hi)); return r; }
__device__ __forceinline__ float bf2f(unsigned short b) { return __uint_as_float(((unsigned)b) << 16); }
__device__ __forceinline__ float sigmoidf_(float x) { return __builtin_amdgcn_rcpf(1.f + __builtin_amdgcn_exp2f(-1.4426950408889634f * x)); }
__device__ __forceinline__ float gelu_tanh(float x) { const float u = 0.7978845608028654f * (x + 0.044715f * x * x * x); return x * sigmoidf_(2.f * u); }
__device__ __forceinline__ float wave_sum(float v) {
#pragma unroll
    for (int o = 1; o < 64; o <<= 1) v += __shfl_xor(v, o);
    return v;
}

namespace pg8 {
constexpr int BM = 256, BK = 64, HALF = 128, HTB = HALF * BK * 2, STAGE_BYTES = 8 * HTB, NXCD = 8, WGM = 8;
__host__ __device__ __forceinline__ int lds_byte(int r, int c) { const int st = (r >> 4) * 2 + (c >> 5), rr = r & 15, cc = c & 31, ob = rr * 64 + cc * 2; return st * 1024 + (ob ^ (((ob >> 9) & 1) << 5)); }
__host__ __device__ __forceinline__ void stage_rc(int b, int& R, int& C) { const int st = b / 1024, sb = b % 1024, swz = sb ^ (((sb >> 9) & 1) << 5); R = (st >> 1) * 16 + swz / 64; C = (st & 1) * 32 + (swz % 64) / 2; }
__host__ __device__ __forceinline__ int perm32(int rho) { const int n = rho >> 4, i = rho & 15; return 8 * (i >> 2) + 4 * n + (i & 3); }

struct Unit { int pm, pn; };
struct Gemm { const bf16_t* A; const bf16_t* Bt; int lda, ldb, K; };

struct StaticOrder {
    int nM, nN, nwg, G, c;
    __device__ void init(int M, int N, int G_, int c_) { nM = M / BM; nN = N / BM; nwg = nM * nN; G = G_; c = c_; }
    __device__ bool next(int i, Unit& u) const {
        const long L = (long)i * G + c; if (L >= nwg) return false;
        int wgid = (int)L; { const int q = nwg / NXCD, r = nwg % NXCD, xcd = wgid % NXCD, off = wgid / NXCD; wgid = (xcd < r ? xcd * (q + 1) : r * (q + 1) + (xcd - r) * q) + off; }
        const int nig = WGM * nN, gid = wgid / nig, fm = gid * WGM, gsz = (nM - fm) < WGM ? (nM - fm) : WGM;
        u.pm = fm + ((wgid % nig) % gsz); u.pn = (wgid % nig) / gsz; return true;
    }
    __device__ __forceinline__ const char* a_base(const Gemm& g, const Unit& u) const { return (const char*)(g.A + (size_t)u.pm * BM * g.lda); }
    __device__ __forceinline__ const char* b_base(const Gemm& g, const Unit& u) const { return (const char*)(g.Bt + (size_t)u.pn * BM * g.ldb); }
};
template <int MODE> struct XaOrder {
    int nwg, G, c, tshift  , seq0;
    __device__ bool next(int i, Unit& u) const { const long L = (long)i * G + c; if (L >= nwg) return false; u.pm = (int)(L >> 2); u.pn = (int)(L & 3); return true; }
    __device__ __forceinline__ const char* a_base(const Gemm& g, const Unit& u) const { return (const char*)(g.A + (size_t)u.pm * BM * g.lda + u.pn * 256); }
    __device__ __forceinline__ const char* b_base(const Gemm& g, const Unit& u) const {
        const int sq = seq0 + (u.pm >> tshift);
        return MODE == 0 ? (const char*)(g.Bt + (size_t)sq * 256 * 1024 + u.pn * 256) : (const char*)(g.Bt + (size_t)(sq * 4 + u.pn) * 65536);
    }
};

struct PmPnOrder {
    int nwg, G, c;
    __device__ bool next(int i, Unit& u) const { const long L = (long)i * G + c; if (L >= nwg) return false; u.pm = (int)(L >> 2); u.pn = (int)(L & 3); return true; }
    __device__ __forceinline__ const char* a_base(const Gemm& g, const Unit& u) const { return (const char*)(g.A + (size_t)u.pm * BM * g.lda); }
    __device__ __forceinline__ const char* b_base(const Gemm& g, const Unit& u) const { return (const char*)(g.Bt + (size_t)u.pn * BM * g.ldb); }
};
template <bool HOOK = false, class Epi, class Sched>
__device__ __forceinline__ void gemm_phase(LAS unsigned char* lds, const Gemm g, const Sched& S, const Epi& E) {
    int tid = threadIdx.x; asm volatile("" : "+v"(tid));
    const int wid = __builtin_amdgcn_readfirstlane(tid >> 6), lane = tid & 63, wr = wid >> 2, wc = wid & 3, fr = lane & 15, fq = lane >> 4;
    int lda = g.lda, ldb = g.ldb, K = g.K; asm volatile("" : "+s"(lda), "+s"(ldb), "+s"(K));
    const int nt = K / BK;
    unsigned voffA[2], voffB[2];
#pragma unroll
    for (int i = 0; i < 2; ++i) { int R, C; stage_rc(tid * 16 + i * 8192, R, C); const int Rb = (R & ~31) + perm32(R & 31);
        voffA[i] = (unsigned)(R * lda + C) * 2u; voffB[i] = (unsigned)(Rb * ldb + C) * 2u; }
    const size_t kstep = (size_t)(BK * 2);
    const size_t hstA = (size_t)HALF * lda * 2, hstB = (size_t)HALF * ldb * 2;
    const unsigned ldsw = (unsigned)wid * 1024u;
    const int aoff = lds_byte(wr * 64 + fr, fq * 8), boff = lds_byte(wc * 32 + fr, fq * 8);
#define PG8_SA(b, h) (((b) * 2 + (h)) * HTB)
#define PG8_SB(b, h) ((4 + (b) * 2 + (h)) * HTB)
#define PG8_STAGE(bufoff, gbase, voff) do { _Pragma("unroll") for (int _i = 0; _i < 2; ++_i) \
        __builtin_amdgcn_global_load_lds((const unsigned*)((const char*)(gbase) + (voff)[_i]), (LAS unsigned*)(lds + (bufoff) + ldsw + _i * 8192), 16, 0, 0); } while (0)
#define PG8_LDA(dst, b, h) do { _Pragma("unroll") for (int m = 0; m < 4; ++m) _Pragma("unroll") for (int k = 0; k < 2; ++k) dst[m][k] = *(const LAS bf16x8*)(lds + PG8_SA(b, h) + aoff + m * 2048 + k * 1024); } while (0)
#define PG8_LDB(dst, b, h) do { _Pragma("unroll") for (int n = 0; n < 2; ++n) _Pragma("unroll") for (int k = 0; k < 2; ++k) dst[n][k] = *(const LAS bf16x8*)(lds + PG8_SB(b, h) + boff + n * 2048 + k * 1024); } while (0)
#define PG8_MMA(ai, bj, At, Bt) do { __builtin_amdgcn_s_setprio(1); _Pragma("unroll") for (int m = 0; m < 4; ++m) _Pragma("unroll") for (int n = 0; n < 2; ++n) _Pragma("unroll") for (int k = 0; k < 2; ++k) \
        acc[ai][bj][m][n] = __builtin_amdgcn_mfma_f32_16x16x32_bf16(Bt[n][k], At[m][k], acc[ai][bj][m][n], 0, 0, 0); __builtin_amdgcn_s_setprio(0); } while (0)
#define PG8_WAIT_V(n) asm volatile("s_waitcnt vmcnt(" #n ")" ::: "memory")
#define PG8_WAIT_L(n) asm volatile("s_waitcnt lgkmcnt(" #n ")" ::: "memory")
#define PG8_BAR __builtin_amdgcn_s_barrier()
#define PG8_SCHED __builtin_amdgcn_sched_barrier(0)
    Unit cur, nxt; int ui = 0;
    if (!S.next(0, cur)) return;
    f32x4 acc[2][2][4][2];
#pragma unroll
    for (int a = 0; a < 2; ++a)
#pragma unroll
        for (int b = 0; b < 2; ++b)
#pragma unroll
            for (int m = 0; m < 4; ++m)
#pragma unroll
                for (int n = 0; n < 2; ++n) acc[a][b][m][n] = (f32x4){0.f, 0.f, 0.f, 0.f};
    bf16x8 At[4][2], B0[2][2], B1[2][2];
    const char* cA = S.a_base(g, cur); const char* cB = S.b_base(g, cur);
    PG8_STAGE(PG8_SB(0, 0), cB, voffB); PG8_STAGE(PG8_SB(0, 1), cB + hstB, voffB); PG8_STAGE(PG8_SA(0, 0), cA, voffA); PG8_STAGE(PG8_SA(0, 1), cA + hstA, voffA);
    if (wr == 1) PG8_BAR;
    PG8_WAIT_V(2); PG8_BAR;
    PG8_STAGE(PG8_SB(1, 0), cB + kstep, voffB); PG8_STAGE(PG8_SA(1, 0), cA + kstep, voffA); PG8_STAGE(PG8_SB(1, 1), cB + hstB + kstep, voffB);
    PG8_WAIT_V(6); PG8_BAR;
    for (;;) {
        const bool has_next = S.next(ui + 1, nxt);
        const char* nA = has_next ? S.a_base(g, nxt) : cA; const char* nB = has_next ? S.b_base(g, nxt) : cB;
        for (int t = 0; t < nt; t += 2) {
            if constexpr (HOOK) { if (t == (nt >> 1)) { E.mid(acc, cur, wr, wc, fr, fq); PG8_WAIT_V(0); } }
            const bool last = (t == nt - 2);
            const char* a1 = cA + (size_t)(t + 1) * kstep;
            const char* a2 = last ? nA : cA + (size_t)(t + 2) * kstep; const char* b2 = last ? nB : cB + (size_t)(t + 2) * kstep;
            const char* a3 = a2 + kstep; const char* b3 = b2 + kstep;
            PG8_LDB(B0, 0, 0); PG8_LDB(B1, 0, 1); PG8_SCHED; PG8_LDA(At, 0, 0); PG8_STAGE(PG8_SA(1, 1), a1 + hstA, voffA);
            PG8_WAIT_V(8); PG8_WAIT_L(0); PG8_BAR; PG8_MMA(0, 0, At, B0); PG8_MMA(0, 1, At, B1); PG8_BAR; PG8_SCHED;
            PG8_LDA(At, 0, 1); PG8_STAGE(PG8_SB(0, 0), b2, voffB); PG8_STAGE(PG8_SB(0, 1), b2 + hstB, voffB); PG8_STAGE(PG8_SA(0, 0), a2, voffA);
            PG8_WAIT_V(8); PG8_WAIT_L(0); PG8_BAR; PG8_MMA(1, 0, At, B0); PG8_MMA(1, 1, At, B1); PG8_BAR; PG8_SCHED;
            PG8_LDB(B0, 1, 0); PG8_LDB(B1, 1, 1); PG8_SCHED; PG8_LDA(At, 1, 0); PG8_STAGE(PG8_SA(0, 1), a2 + hstA, voffA);
            PG8_WAIT_V(8); PG8_WAIT_L(0); PG8_BAR; PG8_MMA(0, 0, At, B0); PG8_MMA(0, 1, At, B1); PG8_BAR; PG8_SCHED;
            PG8_LDA(At, 1, 1); PG8_STAGE(PG8_SB(1, 0), b3, voffB); PG8_STAGE(PG8_SB(1, 1), b3 + hstB, voffB); PG8_STAGE(PG8_SA(1, 0), a3, voffA);
            PG8_WAIT_V(8); PG8_WAIT_L(0); PG8_BAR; PG8_MMA(1, 0, At, B0); PG8_MMA(1, 1, At, B1); PG8_BAR; PG8_SCHED;
        }
        if (wr == 0) PG8_BAR;
        E(acc, cur, wr, wc, fr, fq);
        if (!has_next) break;
#pragma unroll
        for (int a = 0; a < 2; ++a)
#pragma unroll
            for (int b = 0; b < 2; ++b)
#pragma unroll
                for (int m = 0; m < 4; ++m)
#pragma unroll
                    for (int n = 0; n < 2; ++n) acc[a][b][m][n] = (f32x4){0.f, 0.f, 0.f, 0.f};
        cur = nxt; cA = nA; cB = nB; ++ui;
        if (wr == 1) PG8_BAR;
    }
    PG8_WAIT_V(0);
    PG8_BAR;
#undef PG8_SA
#undef PG8_SB
#undef PG8_STAGE
#undef PG8_LDA
#undef PG8_LDB
#undef PG8_MMA
#undef PG8_WAIT_V
#undef PG8_WAIT_L
#undef PG8_BAR
#undef PG8_SCHED
}

typedef f32x4 Acc[2][2][4][2];
__device__ __forceinline__ void st8(bf16_t* p, f32x4 v0, f32x4 v1) { u32x4 w; w.x = cvt_pk_bf16(v0[0], v0[1]); w.y = cvt_pk_bf16(v0[2], v0[3]); w.z = cvt_pk_bf16(v1[0], v1[1]); w.w = cvt_pk_bf16(v1[2], v1[3]); *(u32x4*)p = w; }

struct EpiProj {
    bf16_t* out; const float* rope; int tmask;
    __device__ __forceinline__ void operator()(const Acc& acc, const Unit& u, int wr, int wc, int fr, int fq) const {
        const int seg = u.pn >> 2, colt = (u.pn & 3) * 256;
        bf16_t* base = out + (size_t)seg * SEG_STRIDE;
        const bool do_rope = (seg < 2) && ((wc & 1) == 0);
#pragma unroll
        for (int ai = 0; ai < 2; ++ai)
#pragma unroll
            for (int m = 0; m < 4; ++m) {
                const int row = u.pm * BM + ai * HALF + wr * 64 + m * 16 + fr;
                f32x4 cs0, cs1, sn0, sn1;
                if (do_rope) { const float* rp = rope + (size_t)(row & tmask) * 16; cs0 = *(const f32x4*)rp; cs1 = *(const f32x4*)(rp + 4); sn0 = *(const f32x4*)(rp + 8); sn1 = *(const f32x4*)(rp + 12);
                    if (fq == 0) { sn0 = -sn0; sn1 = -sn1; } }
#pragma unroll
                for (int bj = 0; bj < 2; ++bj) {
                    f32x4 v0 = acc[ai][bj][m][0], v1 = acc[ai][bj][m][1];
                    if (seg < 2) {
                        if (do_rope) {
                            f32x4 p0, p1;
#pragma unroll
                            for (int j = 0; j < 4; ++j) { p0[j] = __shfl_xor(v0[j], 16); p1[j] = __shfl_xor(v1[j], 16); }
                            if (fq < 2) { v0 = v0 * cs0 + p0 * sn0; v1 = v1 * cs1 + p1 * sn1; }
                        }
                        if (seg == 0) { v0 = v0 * 0.18033688011112042f; v1 = v1 * 0.18033688011112042f; }
                    } else if (seg == 4) {
#pragma unroll
                        for (int j = 0; j < 4; ++j) { v0[j] = gelu_tanh(v0[j]); v1[j] = gelu_tanh(v1[j]); }
                    } else if (seg >= 5) {
#pragma unroll
                        for (int j = 0; j < 4; ++j) { v0[j] = sigmoidf_(v0[j]); v1[j] = sigmoidf_(v1[j]); }
                    }
                    st8(base + (size_t)row * 1024 + colt + bj * HALF + wc * 32 + 8 * fq, v0, v1);
                }
            }
    }
};
struct EpiKV {
    bf16_t* Kx; bf16_t* VxT;
    __device__ __forceinline__ void operator()(const Acc& acc, const Unit& u, int wr, int wc, int fr, int fq) const {
#pragma unroll
        for (int ai = 0; ai < 2; ++ai)
#pragma unroll
            for (int m = 0; m < 4; ++m) {
                const int row = u.pm * BM + ai * HALF + wr * 64 + m * 16 + fr;
#pragma unroll
                for (int bj = 0; bj < 2; ++bj) {
                    const f32x4 v0 = acc[ai][bj][m][0], v1 = acc[ai][bj][m][1];
                    const int col = u.pn * BM + bj * HALF + wc * 32 + 8 * fq;
                    if (u.pn < 4) st8(Kx + (size_t)row * 1024 + col, v0, v1);
                    else { const int c = col - 1024, h = c >> 8, dd = c & 255, key = row & 255, sq = row >> 8;
                        bf16_t* p = VxT + ((size_t)(sq * 4 + h) * 256 + dd) * 256 + key;
#pragma unroll
                        for (int j = 0; j < 4; ++j) { p[(size_t)j * 256] = (bf16_t)(cvt_pk_bf16(v0[j], 0.f) & 0xffffu); p[(size_t)(4 + j) * 256] = (bf16_t)(cvt_pk_bf16(v1[j], 0.f) & 0xffffu); } }
                }
            }
    }
};
__device__ __forceinline__ void unpack8(const u32x4 w, f32x4& a, f32x4& b) {
    a = (f32x4){__uint_as_float(w.x << 16), __uint_as_float(w.x & 0xffff0000u), __uint_as_float(w.y << 16), __uint_as_float(w.y & 0xffff0000u)};
    b = (f32x4){__uint_as_float(w.z << 16), __uint_as_float(w.z & 0xffff0000u), __uint_as_float(w.w << 16), __uint_as_float(w.w & 0xffff0000u)};
}
struct EpiGateCat {
    const bf16_t* sa; const bf16_t* sl; bf16_t* out;
    __device__ __forceinline__ static f32x4 ratio4(unsigned a01, unsigned a23, unsigned l01, unsigned l23) {
        f32x4 r;
        r[0] = __uint_as_float(a01 << 16) * __builtin_amdgcn_rcpf(fmaxf(__uint_as_float(l01 << 16), 8.6736174e-19f));
        r[1] = __uint_as_float(a01 & 0xffff0000u) * __builtin_amdgcn_rcpf(fmaxf(__uint_as_float(l01 & 0xffff0000u), 8.6736174e-19f));
        r[2] = __uint_as_float(a23 << 16) * __builtin_amdgcn_rcpf(fmaxf(__uint_as_float(l23 << 16), 8.6736174e-19f));
        r[3] = __uint_as_float(a23 & 0xffff0000u) * __builtin_amdgcn_rcpf(fmaxf(__uint_as_float(l23 & 0xffff0000u), 8.6736174e-19f));
        return r;
    }
    __device__ __forceinline__ void mid(Acc& acc, const Unit& u, int wr, int wc, int fr, int fq) const {
        const GAS bf16_t* sa = (const GAS bf16_t*)this->sa; const GAS bf16_t* sl = (const GAS bf16_t*)this->sl; asm volatile("" : "+s"(sa), "+s"(sl));
#pragma unroll
        for (int ai = 0; ai < 2; ++ai)
#pragma unroll
            for (int mp = 0; mp < 2; ++mp) {
                u32x4 wa[2][2], wl[2][2];
#pragma unroll
                for (int mm = 0; mm < 2; ++mm) { const int m = mp * 2 + mm; const int row = u.pm * BM + ai * HALF + wr * 64 + m * 16 + fr;
#pragma unroll
                    for (int bj = 0; bj < 2; ++bj) { const size_t off = (size_t)row * 1024 + u.pn * BM + bj * HALF + wc * 32 + 8 * fq;
                        wa[mm][bj] = *(const GAS u32x4*)(sa + off); wl[mm][bj] = *(const GAS u32x4*)(sl + off); } }
#pragma unroll
                for (int mm = 0; mm < 2; ++mm) { const int m = mp * 2 + mm;
#pragma unroll
                    for (int bj = 0; bj < 2; ++bj) {
                        acc[ai][bj][m][0] = acc[ai][bj][m][0] * ratio4(wa[mm][bj].x, wa[mm][bj].y, wl[mm][bj].x, wl[mm][bj].y);
                        acc[ai][bj][m][1] = acc[ai][bj][m][1] * ratio4(wa[mm][bj].z, wa[mm][bj].w, wl[mm][bj].z, wl[mm][bj].w);
                        asm volatile("" : "+v"(acc[ai][bj][m][0]), "+v"(acc[ai][bj][m][1]));
                    } }
                asm volatile("" ::: "memory");
            }
    }
    __device__ __forceinline__ void operator()(const Acc& acc, const Unit& u, int wr, int wc, int fr, int fq) const {
#pragma unroll
        for (int ai = 0; ai < 2; ++ai) {
            u32x4 wl[4][2];
#pragma unroll
            for (int m = 0; m < 4; ++m) { const int row = u.pm * BM + ai * HALF + wr * 64 + m * 16 + fr;
#pragma unroll
                for (int bj = 0; bj < 2; ++bj) wl[m][bj] = *(const u32x4*)(sl + (size_t)row * 1024 + u.pn * BM + bj * HALF + wc * 32 + 8 * fq); }
#pragma unroll
            for (int m = 0; m < 4; ++m) { const int row = u.pm * BM + ai * HALF + wr * 64 + m * 16 + fr;
#pragma unroll
                for (int bj = 0; bj < 2; ++bj) {
                    const size_t off = (size_t)row * 1024 + u.pn * BM + bj * HALF + wc * 32 + 8 * fq;
                    f32x4 l0, l1; unpack8(wl[m][bj], l0, l1);
#pragma unroll
                    for (int j = 0; j < 4; ++j) { l0[j] = fmaxf(l0[j], 8.6736174e-19f); l1[j] = fmaxf(l1[j], 8.6736174e-19f); }
                    st8(out + off, acc[ai][bj][m][0] * l0, acc[ai][bj][m][1] * l1);
                }
            }
            asm volatile("" ::: "memory");
        }
    }
};
struct EpiResid {
    const float* res; float* y;
    __device__ __forceinline__ void operator()(const Acc& acc, const Unit& u, int wr, int wc, int fr, int fq) const {
#pragma unroll
        for (int ai = 0; ai < 2; ++ai)
#pragma unroll
            for (int m = 0; m < 4; ++m) {
                const int row = u.pm * BM + ai * HALF + wr * 64 + m * 16 + fr;
#pragma unroll
                for (int bj = 0; bj < 2; ++bj) {
                    const size_t off = (size_t)row * 1024 + u.pn * BM + bj * HALF + wc * 32 + 8 * fq;
                    const f32x4 r0 = *(const f32x4*)(res + off), r1 = *(const f32x4*)(res + off + 4);
                    *(f32x4*)(y + off) = r0 * ALPHA + acc[ai][bj][m][0]; *(f32x4*)(y + off + 4) = r1 * ALPHA + acc[ai][bj][m][1];
                }
                asm volatile("" ::: "memory");
            }
    }
};
struct EpiBf16 {
    bf16_t* out; int ldc; float scale;
    __device__ __forceinline__ void operator()(const Acc& acc, const Unit& u, int wr, int wc, int fr, int fq) const {
#pragma unroll
        for (int ai = 0; ai < 2; ++ai)
#pragma unroll
            for (int m = 0; m < 4; ++m) {
                const int row = u.pm * BM + ai * HALF + wr * 64 + m * 16 + fr;
#pragma unroll
                for (int bj = 0; bj < 2; ++bj)
                    st8(out + (size_t)row * ldc + u.pn * BM + bj * HALF + wc * 32 + 8 * fq, acc[ai][bj][m][0] * scale, acc[ai][bj][m][1] * scale);
                asm volatile("" ::: "memory");
            }
    }
};
struct EpiSwiglu {
    bf16_t* out;
    __device__ __forceinline__ void operator()(const Acc& acc, const Unit& u, int wr, int wc, int fr, int fq) const {
#pragma unroll
        for (int ai = 0; ai < 2; ++ai)
#pragma unroll
            for (int m = 0; m < 4; ++m) {
                const int row = u.pm * BM + ai * HALF + wr * 64 + m * 16 + fr;
                f32x4 h0, h1;
#pragma unroll
                for (int j = 0; j < 4; ++j) { const float g0 = acc[ai][0][m][0][j], g1 = acc[ai][0][m][1][j];
                    h0[j] = g0 * sigmoidf_(g0) * acc[ai][1][m][0][j]; h1[j] = g1 * sigmoidf_(g1) * acc[ai][1][m][1][j]; }
                st8(out + (size_t)row * DFF + u.pn * HALF + wc * 32 + 8 * fq, h0, h1);
            }
    }
};
struct EpiSoftmax {
    bf16_t* P; LAS float* xl;
    __device__ __forceinline__ void operator()(Acc& acc, const Unit& u, int wr, int wc, int fr, int fq) const {
        constexpr float L2E = 1.4426950408889634f;
        LAS float* xw = xl + ((wr * 64 + fr) * 4 + wc) * 2; const LAS float* xr_ = xl + (wr * 64 + fr) * 8;
#pragma unroll
        for (int ai = 0; ai < 2; ++ai)
#pragma unroll
            for (int m = 0; m < 4; ++m) {
                float mx = -3.0e38f;
#pragma unroll
                for (int bj = 0; bj < 2; ++bj)
#pragma unroll
                    for (int n = 0; n < 2; ++n)
#pragma unroll
                        for (int j = 0; j < 4; ++j) mx = fmaxf(mx, acc[ai][bj][m][n][j]);
                mx = fmaxf(mx, __shfl_xor(mx, 16)); mx = fmaxf(mx, __shfl_xor(mx, 32));
                float s = 0.f;
#pragma unroll
                for (int bj = 0; bj < 2; ++bj)
#pragma unroll
                    for (int n = 0; n < 2; ++n)
#pragma unroll
                        for (int j = 0; j < 4; ++j) { const float e = __builtin_amdgcn_exp2f((acc[ai][bj][m][n][j] - mx) * L2E); acc[ai][bj][m][n][j] = e; s += e; }
                s += __shfl_xor(s, 16); s += __shfl_xor(s, 32);
                if (fq == 0) { xw[(ai * HALF + m * 16) * 8] = mx; xw[(ai * HALF + m * 16) * 8 + 1] = s; }
                asm volatile("" ::: "memory");
            }
        asm volatile("s_waitcnt lgkmcnt(0)" ::: "memory"); __builtin_amdgcn_s_barrier(); asm volatile("" ::: "memory");
#pragma unroll
        for (int ai = 0; ai < 2; ++ai)
#pragma unroll
            for (int m = 0; m < 4; ++m) {
                const int r = ai * HALF + wr * 64 + m * 16 + fr; const int row = u.pm * BM + r;
                const f32x4 a = *(const LAS f32x4*)(xr_ + (ai * HALF + m * 16) * 8), b = *(const LAS f32x4*)(xr_ + (ai * HALF + m * 16) * 8 + 4);
                const float M = fmaxf(fmaxf(a[0], a[2]), fmaxf(b[0], b[2]));
                const float tot = a[1] * __builtin_amdgcn_exp2f((a[0] - M) * L2E) + a[3] * __builtin_amdgcn_exp2f((a[2] - M) * L2E) + b[1] * __builtin_amdgcn_exp2f((b[0] - M) * L2E) + b[3] * __builtin_amdgcn_exp2f((b[2] - M) * L2E);
                const float mown = wc == 0 ? a[0] : wc == 1 ? a[2] : wc == 2 ? b[0] : b[2];
                const float f = __builtin_amdgcn_exp2f((mown - M) * L2E) * __builtin_amdgcn_rcpf(tot);
#pragma unroll
                for (int bj = 0; bj < 2; ++bj)
                    st8(P + (size_t)row * 1024 + u.pn * BM + bj * HALF + wc * 32 + 8 * fq, acc[ai][bj][m][0] * f, acc[ai][bj][m][1] * f);
                asm volatile("" ::: "memory");
            }
        asm volatile("s_waitcnt lgkmcnt(0)" ::: "memory"); __builtin_amdgcn_s_barrier(); asm volatile("" ::: "memory");
    }
};

struct LnStats { unsigned long long* xbuf; unsigned* cnt; };
template <bool WB> struct EpiResidLN {
    const float* res; float* yf; bf16_t* yb; const float* g; const float* b; LnStats st; LAS unsigned char* xl;
    __device__ __forceinline__ void operator()(Acc& acc, const Unit& u, int wr, int wc, int fr, int fq) const {
        const int wid = wr * 4 + wc, lane = fq * 16 + fr;
        LAS f32x2* P = (LAS f32x2*)xl; LAS f32x2* S = (LAS f32x2*)(xl + 8192); LAS unsigned* flag = (LAS unsigned*)(xl + 8192 + 2048);
#pragma unroll
        for (int ai = 0; ai < 2; ++ai) {
            f32x4 rv[4][2][2];
#pragma unroll
            for (int m = 0; m < 4; ++m) {
                const int row = u.pm * BM + ai * HALF + wr * 64 + m * 16 + fr;
#pragma unroll
                for (int bj = 0; bj < 2; ++bj) {
                    const size_t off = (size_t)row * 1024 + u.pn * BM + bj * HALF + wc * 32 + 8 * fq;
                    rv[m][bj][0] = *(const f32x4*)(res + off); rv[m][bj][1] = *(const f32x4*)(res + off + 4);
                }
            }
#pragma unroll
            for (int m = 0; m < 4; ++m) {
#pragma unroll
                for (int bj = 0; bj < 2; ++bj) { acc[ai][bj][m][0] = rv[m][bj][0] * ALPHA + acc[ai][bj][m][0]; acc[ai][bj][m][1] = rv[m][bj][1] * ALPHA + acc[ai][bj][m][1]; }
                asm volatile("" : "+v"(acc[ai][0][m][0]), "+v"(acc[ai][0][m][1]), "+v"(acc[ai][1][m][0]), "+v"(acc[ai][1][m][1]));
            }
            asm volatile("" ::: "memory");
        }
        f32x4 gv[2][2], bv[2][2];
#pragma unroll
        for (int bj = 0; bj < 2; ++bj)
#pragma unroll
            for (int n = 0; n < 2; ++n) { const int col = u.pn * BM + bj * HALF + wc * 32 + 8 * fq + 4 * n; gv[bj][n] = *(const f32x4*)(g + col); bv[bj][n] = *(const f32x4*)(b + col); }
#pragma unroll
        for (int ai = 0; ai < 2; ++ai)
#pragma unroll
            for (int m = 0; m < 4; ++m) {
                float s = 0.f;
#pragma unroll
                for (int bj = 0; bj < 2; ++bj)
#pragma unroll
                    for (int n = 0; n < 2; ++n) { const f32x4 x = acc[ai][bj][m][n]; s += (x[0] + x[1]) + (x[2] + x[3]); }
                s += __shfl_xor(s, 16); s += __shfl_xor(s, 32);
                const float mw = s * (1.0f / 64.0f); float q = 0.f;
#pragma unroll
                for (int bj = 0; bj < 2; ++bj)
#pragma unroll
                    for (int n = 0; n < 2; ++n) { const f32x4 d = acc[ai][bj][m][n] - mw; q += (d[0] * d[0] + d[1] * d[1]) + (d[2] * d[2] + d[3] * d[3]); }
                q += __shfl_xor(q, 16); q += __shfl_xor(q, 32);
                if (fq == 0) P[(ai * HALF + wr * 64 + m * 16 + fr) * 4 + wc] = (f32x2){mw, q};
            }
        asm volatile("s_waitcnt lgkmcnt(0)" ::: "memory"); __builtin_amdgcn_s_barrier(); asm volatile("" ::: "memory");
        const int row = wid * 32 + (lane & 31);
        unsigned* cw = st.cnt + 16 * u.pm;
        if (lane < 32) {
            const f32x2 a = P[row * 4 + 0], b2 = P[row * 4 + 1], c = P[row * 4 + 2], d = P[row * 4 + 3];
            const float mt = (a.x + b2.x + c.x + d.x) * 0.25f;
            const float da = a.x - mt, db = b2.x - mt, dc = c.x - mt, dd = d.x - mt;
            const float m2 = (a.y + b2.y) + (c.y + d.y) + 64.0f * ((da * da + db * db) + (dc * dc + dd * dd));
            unsigned long long* slot = st.xbuf + ((size_t)(u.pm * BM + row) * 4 + u.pn);
            __hip_atomic_store(slot, ((unsigned long long)__float_as_uint(m2) << 32) | __float_as_uint(mt), __ATOMIC_RELAXED, __HIP_MEMORY_SCOPE_AGENT);
        }
        asm volatile("s_waitcnt vmcnt(0)" ::: "memory");
        if (lane == 0) __hip_atomic_fetch_add(cw, 1u, __ATOMIC_RELAXED, __HIP_MEMORY_SCOPE_AGENT);
        if (wid == 0) {
            unsigned sp = 0;
            while ((unsigned)__builtin_amdgcn_readfirstlane(__hip_atomic_load(cw, __ATOMIC_RELAXED, __HIP_MEMORY_SCOPE_AGENT)) < 32u) { __builtin_amdgcn_s_sleep(2); if (++sp > (1u << 22)) break; }
            __builtin_amdgcn_fence(__ATOMIC_ACQUIRE, "agent");
            if (lane == 0) flag[0] = 0u;
        }
        asm volatile("s_waitcnt vmcnt(0) lgkmcnt(0)" ::: "memory"); __builtin_amdgcn_s_barrier(); asm volatile("" ::: "memory");
        if (lane < 32) {
            const unsigned long long* slot = st.xbuf + (size_t)(u.pm * BM + row) * 4; float mt[4], m2[4]; float ms = 0.f;
#pragma unroll
            for (int t = 0; t < 4; ++t) { const unsigned long long w = __hip_atomic_load(slot + t, __ATOMIC_RELAXED, __HIP_MEMORY_SCOPE_AGENT); mt[t] = __uint_as_float((unsigned)w); m2[t] = __uint_as_float((unsigned)(w >> 32)); ms += mt[t]; }
            const float mean = ms * 0.25f; float q = 0.f;
#pragma unroll
            for (int t = 0; t < 4; ++t) { const float dm = mt[t] - mean; q += m2[t] + 256.0f * dm * dm; }
            S[row] = (f32x2){mean, rsqrtf(q * (1.f / 1024.f) + LN_EPS)};
        }
        asm volatile("s_waitcnt lgkmcnt(0)" ::: "memory"); __builtin_amdgcn_s_barrier(); asm volatile("" ::: "memory");
#pragma unroll
        for (int ai = 0; ai < 2; ++ai)
#pragma unroll
            for (int m = 0; m < 4; ++m) {
                const int r = ai * HALF + wr * 64 + m * 16 + fr; const f32x2 sr = S[r];
#pragma unroll
                for (int bj = 0; bj < 2; ++bj) {
                    const size_t off = (size_t)(u.pm * BM + r) * 1024 + u.pn * BM + bj * HALF + wc * 32 + 8 * fq;
                    const f32x4 o0 = (acc[ai][bj][m][0] - sr.x) * sr.y * gv[bj][0] + bv[bj][0], o1 = (acc[ai][bj][m][1] - sr.x) * sr.y * gv[bj][1] + bv[bj][1];
                    *(f32x4*)(yf + off) = o0; *(f32x4*)(yf + off + 4) = o1;
                    if (WB) st8(yb + off, o0, o1);
                }
                asm volatile("" ::: "memory");
            }
        asm volatile("s_waitcnt lgkmcnt(0)" ::: "memory"); __builtin_amdgcn_s_barrier(); asm volatile("" ::: "memory");
    }
};
}

namespace dattn {
constexpr int KVBLK = 64, LDK = 1024;
constexpr size_t SHM_V = KVBLK * 128 * 2, SHM_K = KVBLK * 128 * 2;
constexpr int WS_OFF = 2 * SHM_V + 2 * SHM_K, EXCH_OFF = WS_OFF + NWAVES * 64 * 4;
constexpr float THR = 8.f;
#define KSWZ(row, colB) ((row) * 256 + ((colB) ^ (((row) & 7) << 4)))
#define SBAR() __builtin_amdgcn_sched_barrier(0)
__device__ __forceinline__ int crow(int r, int hi) { return (r & 3) + 8 * (r >> 2) + 4 * hi; }
constexpr float THR2 = THR * 1.4426950408889634f;
template <bool FIRST> __device__ __forceinline__ void partialSM(f32x16& p0, f32x16& p1, float& m_reg, f32x16& negm, float& alpha) {
  float pmax = p0[0];
#pragma unroll
  for (int r = 1; r < 16; ++r) pmax = fmaxf(pmax, p0[r]);
#pragma unroll
  for (int r = 0; r < 16; ++r) pmax = fmaxf(pmax, p1[r]);
  { auto rr = __builtin_amdgcn_permlane32_swap(__float_as_uint(pmax), __float_as_uint(pmax), false, false);
    pmax = fmaxf(__uint_as_float(rr[0]), __uint_as_float(rr[1])); }
  if (!FIRST && __builtin_expect(__all(pmax <= THR2), 1)) { alpha = 1.f; }
  else { const float d = FIRST ? pmax : fmaxf(pmax, 0.f); m_reg += d; alpha = FIRST ? 1.f : __builtin_amdgcn_exp2f(-d);
#pragma unroll
    for (int r = 0; r < 16; ++r) { p0[r] -= d; p1[r] -= d; }
#pragma unroll
    for (int r = 0; r < 16; ++r) negm[r] = -m_reg;
    asm volatile("" : "+v"(negm)); }
#pragma unroll
  for (int r = 0; r < 16; ++r) p0[r] = __builtin_amdgcn_exp2f(p0[r]);
}
__device__ __forceinline__ void finishSM(f32x16& p0, f32x16& p1, float alpha, float& l_reg, bf16x8& pa0, bf16x8& pa1, bf16x8& pa2, bf16x8& pa3, bool do_exp = true) {
  if (do_exp) {
#pragma unroll
  for (int r = 0; r < 16; ++r) p1[r] = __builtin_amdgcn_exp2f(p1[r]); }
  float ps = 0;
#pragma unroll
  for (int r = 0; r < 16; ++r) ps += p0[r];
#pragma unroll
  for (int r = 0; r < 16; ++r) ps += p1[r];
  { auto rr = __builtin_amdgcn_permlane32_swap(__float_as_uint(ps), __float_as_uint(ps), false, false);
    ps = __uint_as_float(rr[0]) + __uint_as_float(rr[1]); }
  l_reg = l_reg * alpha + ps;
#define PK4(P, BASE, OUT) do { unsigned a0 = cvt_pk_bf16(P[BASE + 0], P[BASE + 1]), a1 = cvt_pk_bf16(P[BASE + 2], P[BASE + 3]);   \
    unsigned b0 = cvt_pk_bf16(P[BASE + 4], P[BASE + 5]), b1 = cvt_pk_bf16(P[BASE + 6], P[BASE + 7]);                              \
    auto r0 = __builtin_amdgcn_permlane32_swap(a0, b0, false, false); auto r1 = __builtin_amdgcn_permlane32_swap(a1, b1, false, false); \
    u32x4 w = {r0[0], r1[0], r0[1], r1[1]}; OUT = *reinterpret_cast<bf16x8*>(&w); } while (0)
  PK4(p0, 0, pa0); PK4(p0, 8, pa1); PK4(p1, 0, pa2); PK4(p1, 8, pa3);
#undef PK4
}
template <bool FIRST> __device__ __forceinline__ void rowmaxSM(f32x16& p0, f32x16& p1, float& m_reg, f32x16& negm, float& alpha) {
  float pmax = p0[0];
#pragma unroll
  for (int r = 1; r < 16; ++r) pmax = fmaxf(pmax, p0[r]);
#pragma unroll
  for (int r = 0; r < 16; ++r) pmax = fmaxf(pmax, p1[r]);
  { auto rr = __builtin_amdgcn_permlane32_swap(__float_as_uint(pmax), __float_as_uint(pmax), false, false);
    pmax = fmaxf(__uint_as_float(rr[0]), __uint_as_float(rr[1])); }
  if (!FIRST && __builtin_expect(__all(pmax <= THR2), 1)) { alpha = 1.f; }
  else { const float d = FIRST ? pmax : fmaxf(pmax, 0.f); m_reg += d; alpha = FIRST ? 1.f : __builtin_amdgcn_exp2f(-d);
#pragma unroll
    for (int r = 0; r < 16; ++r) { p0[r] -= d; p1[r] -= d; }
#pragma unroll
    for (int r = 0; r < 16; ++r) negm[r] = -m_reg;
    asm volatile("" : "+v"(negm)); }
}
typedef short v4i16_t __attribute__((ext_vector_type(4)));
__device__ __forceinline__ s16x4 vtr(const LAS char* p) { return __builtin_bit_cast(s16x4, __builtin_amdgcn_ds_read_tr16_b64_v4i16((LAS v4i16_t*)p)); }
#define MF32(a, b, c) __builtin_amdgcn_mfma_f32_32x32x16_bf16(a, b, c, 0, 0, 0)
__device__ __forceinline__ void seg1(f32x16& C0, f32x16& C1, const f32x16& P0, const f32x16& P1, float alP, bf16x8& pa0, bf16x8& pa1, bf16x8& pa2, bf16x8& pa3,
                                     const LAS char* Ks, const bf16x8* qr, const f32x16& negm, int r32, int hi, int cofs) {
  unsigned rr[4][2][2];
#define KLD(d0, half) (*reinterpret_cast<const LAS bf16x8*>(Ks + KSWZ((half) * 32 + r32, ((cofs + (d0) * 16 + hi * 8) * 2))))
  bf16x8 kf[4][2];
#pragma unroll
  for (int d0 = 0; d0 < 4; ++d0) { kf[d0][0] = KLD(d0, 0); kf[d0][1] = KLD(d0, 1); }
  SBAR();
#pragma unroll
  for (int d0 = 0; d0 < 4; ++d0) {
    const bf16x8 ka = kf[d0][0], kb = kf[d0][1];
#pragma unroll
    for (int h2 = 0; h2 < 2; ++h2) { const int i = 2 * d0 + h2;
      if (h2 == 0) C0 = MF32(ka, qr[d0], d0 == 0 ? negm : C0); else C1 = MF32(kb, qr[d0], d0 == 0 ? negm : C1);
      { const int g = i >> 1, hf = i & 1, base = (g & 1) * 8 + hf * 2;
        const unsigned a_ = g < 2 ? cvt_pk_bf16(P0[base], P0[base + 1]) : cvt_pk_bf16(P1[base], P1[base + 1]);
        const unsigned b_ = g < 2 ? cvt_pk_bf16(P0[base + 4], P0[base + 5]) : cvt_pk_bf16(P1[base + 4], P1[base + 5]);
        auto r_ = __builtin_amdgcn_permlane32_swap(a_, b_, false, false); rr[g][hf][0] = r_[0]; rr[g][hf][1] = r_[1]; }
      SBAR();
    }
  }
#undef KLD
  { u32x4 w = {rr[0][0][0], rr[0][1][0], rr[0][0][1], rr[0][1][1]}; pa0 = *reinterpret_cast<bf16x8*>(&w); }
  { u32x4 w = {rr[1][0][0], rr[1][1][0], rr[1][0][1], rr[1][1][1]}; pa1 = *reinterpret_cast<bf16x8*>(&w); }
  { u32x4 w = {rr[2][0][0], rr[2][1][0], rr[2][0][1], rr[2][1][1]}; pa2 = *reinterpret_cast<bf16x8*>(&w); }
  { u32x4 w = {rr[3][0][0], rr[3][1][0], rr[3][0][1], rr[3][1][1]}; pa3 = *reinterpret_cast<bf16x8*>(&w); }
}
template <bool EXPS> __device__ __forceinline__ void seg2(f32x16* o, f32x16& ol, const LAS char* vp, bf16x8 pa0, bf16x8 pa1, bf16x8 pa2, bf16x8 pa3, f32x16& C0, f32x16& C1) {
#define VOFF(n, half) ((((n) >> 2) * 512) + (((n) & 3) * 4096) + (half) * 2048)
  constexpr int DEPTH = 4;
  s16x4 lo[DEPTH], hi_[DEPTH];
#pragma unroll
  for (int n = 0; n < DEPTH; ++n) { lo[n] = vtr(vp + VOFF(n, 0)); hi_[n] = vtr(vp + VOFF(n, 1)); }
  SBAR();
#pragma unroll
  for (int n = 0; n < 16; ++n) {
    const int sl = n % DEPTH;
    const bf16x8 vf = (bf16x8){lo[sl][0], lo[sl][1], lo[sl][2], lo[sl][3], hi_[sl][0], hi_[sl][1], hi_[sl][2], hi_[sl][3]};
    const int ks = n & 3, d0 = n >> 2;
    o[d0] = MF32(ks == 0 ? pa0 : ks == 1 ? pa1 : ks == 2 ? pa2 : pa3, vf, o[d0]);
    if (n + DEPTH < 16) { lo[sl] = vtr(vp + VOFF(n + DEPTH, 0)); hi_[sl] = vtr(vp + VOFF(n + DEPTH, 1)); }
    if (EXPS) {
      if (n < 8) { C0[2 * n] = __builtin_amdgcn_exp2f(C0[2 * n]); C0[2 * n + 1] = __builtin_amdgcn_exp2f(C0[2 * n + 1]); asm volatile("" : "+v"(C0)); }
      else { C1[2 * n - 16] = __builtin_amdgcn_exp2f(C1[2 * n - 16]); C1[2 * n - 15] = __builtin_amdgcn_exp2f(C1[2 * n - 15]); asm volatile("" : "+v"(C1)); }
    }
    SBAR();
  }
  { const bf16x8 ones = {0x3F80, 0x3F80, 0x3F80, 0x3F80, 0x3F80, 0x3F80, 0x3F80, 0x3F80};
    ol = MF32(pa0, ones, ol); ol = MF32(pa1, ones, ol); ol = MF32(pa2, ones, ol); ol = MF32(pa3, ones, ol); }
#undef VOFF
}
__device__ __forceinline__ void qkt(f32x16& p0, f32x16& p1, const char* Ks, const bf16x8* qr, int r32, int hi, int cofs, const f32x16& negm) {
#pragma unroll
  for (int d0 = 0; d0 < 4; ++d0) { int cb = (cofs + d0 * 16 + hi * 8) * 2;
    bf16x8 b0 = *reinterpret_cast<const bf16x8*>(Ks + KSWZ(r32, cb));
    bf16x8 b1 = *reinterpret_cast<const bf16x8*>(Ks + KSWZ(32 + r32, cb));
    if (d0 == 0) { p0 = __builtin_amdgcn_mfma_f32_32x32x16_bf16(b0, qr[0], negm, 0, 0, 0); p1 = __builtin_amdgcn_mfma_f32_32x32x16_bf16(b1, qr[0], negm, 0, 0, 0); }
    else { p0 = __builtin_amdgcn_mfma_f32_32x32x16_bf16(b0, qr[d0], p0, 0, 0, 0); p1 = __builtin_amdgcn_mfma_f32_32x32x16_bf16(b1, qr[d0], p1, 0, 0, 0); } }
}
__device__ __forceinline__ int v_st(int k, int c) { const int kk = (k & ~0xC) | ((k & 4) << 1) | ((k & 8) >> 1); return ((kk >> 3) * 4 + (c >> 5)) * 512 + ((kk & 7) * 32 + (c & 31)) * 2; }
__device__ __forceinline__ int v_rd_base(int lane) { return ((lane & 3) << 3) | (((lane >> 2) & 3) << 6) | (((lane >> 4) & 1) << 5) | (((lane >> 5) & 1) << 8); }
constexpr int v_rd_off(int d0, int ks, int half) { return d0 * 512 + ks * 4096 + half * 2048; }
template <int OFF> __device__ __forceinline__ s16x4 tr_read(int vb) {
  s16x4 r; asm volatile("ds_read_b64_tr_b16 %0, %1 offset:%2" : "=&v"(r) : "v"(vb), "i"(OFF) : "memory"); return r;
}
template <int D0> __device__ __forceinline__ void pv_one(f32x16& od, int vb, bf16x8 pa0, bf16x8 pa1, bf16x8 pa2, bf16x8 pa3) {
  const s16x4 l0 = tr_read<v_rd_off(D0, 0, 0)>(vb), h0 = tr_read<v_rd_off(D0, 0, 1)>(vb), l1 = tr_read<v_rd_off(D0, 1, 0)>(vb), h1 = tr_read<v_rd_off(D0, 1, 1)>(vb);
  const s16x4 l2 = tr_read<v_rd_off(D0, 2, 0)>(vb), h2 = tr_read<v_rd_off(D0, 2, 1)>(vb), l3 = tr_read<v_rd_off(D0, 3, 0)>(vb), h3 = tr_read<v_rd_off(D0, 3, 1)>(vb);
  asm volatile("s_waitcnt lgkmcnt(0)" ::: "memory"); SBAR();
#define PK(L, H) (bf16x8){L[0], L[1], L[2], L[3], H[0], H[1], H[2], H[3]}
  od = __builtin_amdgcn_mfma_f32_32x32x16_bf16(pa0, PK(l0, h0), od, 0, 0, 0);
  od = __builtin_amdgcn_mfma_f32_32x32x16_bf16(pa1, PK(l1, h1), od, 0, 0, 0);
  od = __builtin_amdgcn_mfma_f32_32x32x16_bf16(pa2, PK(l2, h2), od, 0, 0, 0);
  od = __builtin_amdgcn_mfma_f32_32x32x16_bf16(pa3, PK(l3, h3), od, 0, 0, 0);
#undef PK
}
__device__ __forceinline__ void pv_d0(f32x16* o, int vb, bf16x8 pa0, bf16x8 pa1, bf16x8 pa2, bf16x8 pa3) {
  pv_one<0>(o[0], vb, pa0, pa1, pa2, pa3); pv_one<1>(o[1], vb, pa0, pa1, pa2, pa3); pv_one<2>(o[2], vb, pa0, pa1, pa2, pa3); pv_one<3>(o[3], vb, pa0, pa1, pa2, pa3);
}
__device__ __forceinline__ void unit(const bf16_t* __restrict__ Qb, const bf16_t* __restrict__ Kh, const bf16_t* __restrict__ Vh, bf16_t* __restrict__ Ob, int ldo, int seq,
                                     char* lds, float lam, const float* __restrict__ subg, int pend, LAS int* slot) {
  int tid = threadIdx.x; asm volatile("" : "+v"(tid));
  const int wid = __builtin_amdgcn_readfirstlane(tid >> 6), lane = tid & 63, r32 = lane & 31, hi = lane >> 5;
  const int comp = wid & 1, rg = wid >> 1, cofs = comp * 64;
  char* V_lds = lds; char* K_lds = lds + 2 * SHM_V;
  float* ws = (float*)(lds + WS_OFF) + wid * 64; float* li_l = ws; float* al_l = ws + 32;
  float m_reg = 0.f; f32x16 o[4] = {}; f32x16 ol = {}; bf16x8 qr[4];
  const bf16_t* Qw = Qb + (long)(rg * 32 + r32) * 1024 + cofs + hi * 8;
#pragma unroll
  for (int d0 = 0; d0 < 4; ++d0) qr[d0] = *reinterpret_cast<const bf16x8*>(Qw + d0 * 16);
  const int sr = tid >> 4, sc = (tid & 15) * 8, vst0 = v_st(sr, sc), vst1 = v_st(32 + sr, sc);
  const int vb0 = (int)(uintptr_t)V_lds + v_rd_base(lane);
  struct { bf16x8 vs0, vs1, ks0, ks1; } sr_[1];
#define LD8(p) (*reinterpret_cast<const bf16x8*>(p))
#define SLOAD(i, k0) do { sr_[i].vs0 = LD8(&Vh[(long)((k0) + sr) * LDK + sc]); sr_[i].vs1 = LD8(&Vh[(long)((k0) + 32 + sr) * LDK + sc]); \
    sr_[i].ks0 = LD8(&Kh[(long)((k0) + sr) * LDK + sc]); sr_[i].ks1 = LD8(&Kh[(long)((k0) + 32 + sr) * LDK + sc]); } while (0)
#define SWRITE(b, i) do { *(bf16x8*)(V_lds + (b) * SHM_V + vst0) = sr_[i].vs0;          \
    *(bf16x8*)(V_lds + (b) * SHM_V + vst1) = sr_[i].vs1; int kc = sc * 2;               \
    *(bf16x8*)(K_lds + (b) * SHM_K + KSWZ(sr, kc)) = sr_[i].ks0;                       \
    *(bf16x8*)(K_lds + (b) * SHM_K + KSWZ(32 + sr, kc)) = sr_[i].ks1; } while (0)
#define SWAIT() asm volatile("s_waitcnt vmcnt(4)" ::: "memory")
#define RESC(a) do { if (__any((a) < 1.f)) { if (hi == 0) al_l[r32] = (a); asm volatile("s_waitcnt lgkmcnt(0)" ::: "memory"); \
    _Pragma("unroll") for (int r = 0; r < 16; ++r) { const float f_ = al_l[crow(r, hi)]; ol[r] *= f_; _Pragma("unroll") for (int d = 0; d < 4; ++d) o[d][r] *= f_; } } } while (0)
  f32x16 pA0, pA1, pB0, pB1; float alA, alB; f32x16 negm = {}; asm volatile("" : "+v"(negm)); bf16x8 pa0, pa1, pa2, pa3; const int NT = seq / KVBLK;
  const LAS char* Kl = (const LAS char*)K_lds; const LAS char* Vl = (const LAS char*)V_lds + v_rd_base(lane);
  SLOAD(0, 0); asm volatile("s_waitcnt vmcnt(0)" ::: "memory"); SWRITE(0, 0); SLOAD(0, KVBLK); __syncthreads();
  if (tid == 0) *slot = pend;
  qkt(pA0, pA1, K_lds, qr, r32, hi, cofs, negm); rowmaxSM<true>(pA0, pA1, m_reg, negm, alA);
#pragma unroll
  for (int r = 0; r < 16; ++r) { pA0[r] = __builtin_amdgcn_exp2f(pA0[r]); pA1[r] = __builtin_amdgcn_exp2f(pA1[r]); }
  asm volatile("s_waitcnt vmcnt(0)" ::: "memory"); SWRITE(1, 0); SLOAD(0, 2 * KVBLK); __syncthreads();
#pragma unroll 1
  for (int j = 1; j + 1 < NT; j += 2) {
    SBAR(); seg1(pB0, pB1, pA0, pA1, alA, pa0, pa1, pa2, pa3, Kl + SHM_K, qr, negm, r32, hi, cofs);
    rowmaxSM<false>(pB0, pB1, m_reg, negm, alB); SBAR();
    seg2<true>(o, ol, Vl, pa0, pa1, pa2, pa3, pB0, pB1);
    __syncthreads(); asm volatile("s_waitcnt vmcnt(0)" ::: "memory"); SWRITE(0, 0); SLOAD(0, (j + 2) * KVBLK);
    RESC(alB); __syncthreads();
    SBAR(); seg1(pA0, pA1, pB0, pB1, alB, pa0, pa1, pa2, pa3, Kl, qr, negm, r32, hi, cofs);
    rowmaxSM<false>(pA0, pA1, m_reg, negm, alA); SBAR();
    seg2<true>(o, ol, Vl + SHM_V, pa0, pa1, pa2, pa3, pA0, pA1);
    __syncthreads(); asm volatile("s_waitcnt vmcnt(0)" ::: "memory"); SWRITE(1, 0); if (j + 3 < NT) SLOAD(0, (j + 3) * KVBLK);
    RESC(alA); __syncthreads();
  }
  SBAR(); seg1(pB0, pB1, pA0, pA1, alA, pa0, pa1, pa2, pa3, Kl + SHM_K, qr, negm, r32, hi, cofs); SBAR();
  rowmaxSM<false>(pB0, pB1, m_reg, negm, alB); SBAR();
  seg2<true>(o, ol, Vl, pa0, pa1, pa2, pa3, pB0, pB1);
  __syncthreads(); RESC(alB);
  { float dl = 0.f; finishSM(pB0, pB1, alB, dl, pa0, pa1, pa2, pa3, false); } SBAR();
  seg2<false>(o, ol, Vl + SHM_V, pa0, pa1, pa2, pa3, pB0, pB1);
  float rli[16];
#pragma unroll
  for (int r = 0; r < 16; ++r) rli[r] = __builtin_amdgcn_rcpf(ol[r]);
  float* ex = (float*)(lds + EXCH_OFF) + rg * 4096;
  if (comp == 1) {
#pragma unroll
    for (int d0 = 0; d0 < 4; ++d0)
#pragma unroll
      for (int r = 0; r < 16; ++r) ex[(d0 * 16 + r) * 64 + lane] = o[d0][r] * rli[r] * lam;
  }
  float gv[4];
#pragma unroll
  for (int d0 = 0; d0 < 4; ++d0) gv[d0] = subg[d0 * 32 + r32] * (1.f - LAMBDA_INIT);
  __syncthreads();
  if (comp == 0) {
#pragma unroll
    for (int r = 0; r < 16; ++r)
#pragma unroll
      for (int d0 = 0; d0 < 4; ++d0) o[d0][r] = o[d0][r] * rli[r] - ex[(d0 * 16 + r) * 64 + lane];
    asm volatile("s_waitcnt lgkmcnt(0)" ::: "memory");
    char* stg = (char*)ex;
#pragma unroll
    for (int r = 0; r < 16; ++r) {
      float ss = 0.f;
#pragma unroll
      for (int d0 = 0; d0 < 4; ++d0) ss += o[d0][r] * o[d0][r];
#pragma unroll
      for (int s = 1; s < 32; s <<= 1) ss += __shfl_xor(ss, s);
      const float rs = rsqrtf(ss * (1.f / 128.f) + SUBLN_EPS);
      bf16_t* srow = (bf16_t*)(stg + crow(r, hi) * 272) + r32;
#pragma unroll
      for (int d0 = 0; d0 < 4; ++d0) srow[d0 * 32] = (bf16_t)(cvt_pk_bf16(o[d0][r] * rs * gv[d0], 0.f) & 0xffffu);
    }
    asm volatile("s_waitcnt lgkmcnt(0)" ::: "memory");
#pragma unroll
    for (int i = 0; i < 8; ++i) { const int row = i * 4 + (lane >> 4), ch = lane & 15;
      const u32x4 v = *(const u32x4*)(stg + row * 272 + ch * 16);
      *(u32x4*)(Ob + (long)(rg * 32 + row) * ldo + ch * 8) = v; }
  }
  __syncthreads();
#undef LD8
#undef SLOAD
#undef SWRITE
#undef SWAIT
#undef RESC
}
#undef SBAR
}

namespace lru {
constexpr int CH = 64, AST = 272;
constexpr int L_A = 0, L_XCF = 17408, L_G = L_XCF + 32768, L_PS = L_G + 65536;
struct Params { const bf16_t* xr; bf16_t* hf; const bf16_t* gyr; bf16_t* lo; const bf16_t* Wt; const float* conv_w; const float* conv_b; const float* ba; const float* bx; const float* aparam; };
__device__ __forceinline__ void unit(const Params& P, int uid, int Tseq, char* lds) {
  int tid = threadIdx.x; asm volatile("" : "+v"(tid));
  const int wid = __builtin_amdgcn_readfirstlane(tid >> 6), lane = tid & 63, r32 = lane & 31, hi = lane >> 5;
  const int nb = uid & 7, sq = uid >> 3;
  const long rowbase = (long)sq * Tseq; const int cb0 = nb * 128;
  const int cg8 = tid & 15, tgp = tid >> 4; const int cch = cb0 + cg8 * 8;
  const int gate = wid & 1, cgp = wid >> 1;
  const int c = tid & 127, sg = tid >> 7;
  const int nch = Tseq / CH;
  const bf16_t* xcol = P.xr + (size_t)rowbase * 1024 + cch;
  bf16_t* hfcol = P.hf + (size_t)rowbase * 1024 + cb0 + c;
  const bf16_t* gcol = P.gyr + (size_t)rowbase * 1024 + cb0 + c;
  bf16_t* locol = P.lo + (size_t)rowbase * 2048 + 1024 + cb0 + c;
  float* xcf = (float*)(lds + L_XCF); float* G = (float*)(lds + L_G); f32x2* PS = (f32x2*)(lds + L_PS);
  float* cwl = (float*)(lds + L_PS + 4096);
  if (tid < 160) { const int j = tid >> 5, c4 = (tid & 31) * 4; const float* srcp = j < 4 ? P.conv_w + j * 1024 + cb0 + c4 : P.conv_b + cb0 + c4; *(f32x4*)(cwl + j * 128 + c4) = *(const f32x4*)srcp; }
  __syncthreads();
#pragma unroll 1
  for (int dir = 0; dir < 2; ++dir) {
    const float gbias = (gate == 0 ? P.ba : P.bx)[dir * 1024 + cb0 + cgp * 32 + r32];
    float sp; { const float z = -P.aparam[dir * 1024 + cb0 + c]; sp = fmaxf(z, 0.f) + log1pf(__expf(-fabsf(z))); }
    const float spl = -8.f * 1.4426950408889634f * sp;
    float carry = 0.f;
    bf16x8 xin[5];
#define LRU_LOAD(cc) do { const int tb = (cc) * CH + 2 * tgp - 2; _Pragma("unroll") for (int i = 0; i < 5; ++i) { const int t = tb + i; \
      xin[i] = (t >= 0 && t < Tseq) ? *(const bf16x8*)(xcol + (size_t)t * 1024) : (bf16x8){0, 0, 0, 0, 0, 0, 0, 0}; } } while (0)
    LRU_LOAD(dir ? nch - 1 : 0);
#pragma unroll 1
    for (int ci = 0; ci < nch; ++ci) {
      const int cc = dir ? nch - 1 - ci : ci, t0 = cc * CH;
      bf16x8 bfr[8];
      { const bf16_t* wt = P.Wt; asm volatile("" : "+s"(wt));
        const GAS bf16_t* wp = (const GAS bf16_t*)(wt + ((size_t)((dir * 2 + gate) * 8 + nb)) * 16384 + (size_t)(cgp * 32 + r32) * 128 + hi * 8);
#pragma unroll
        for (int ks = 0; ks < 8; ++ks) bfr[ks] = *(const GAS bf16x8*)(wp + ks * 16); }
      { float cw[4][8], cbias[8];
        {
#pragma unroll
          for (int j = 0; j < 4; ++j) { const f32x4 a = *(const f32x4*)(cwl + j * 128 + cg8 * 8), b = *(const f32x4*)(cwl + j * 128 + cg8 * 8 + 4);
#pragma unroll
            for (int e = 0; e < 4; ++e) { cw[j][e] = a[e]; cw[j][4 + e] = b[e]; } }
          const f32x4 a = *(const f32x4*)(cwl + 512 + cg8 * 8), b = *(const f32x4*)(cwl + 512 + cg8 * 8 + 4);
#pragma unroll
          for (int e = 0; e < 4; ++e) { cbias[e] = a[e]; cbias[4 + e] = b[e]; } }
        float xf[5][8];
#pragma unroll
        for (int i = 0; i < 5; ++i)
#pragma unroll
          for (int e = 0; e < 8; ++e) xf[i][e] = bf2f((unsigned short)xin[i][e]);
#pragma unroll
        for (int i = 0; i < 2; ++i) {
          float xc[8];
#pragma unroll
          for (int e = 0; e < 8; ++e) xc[e] = cbias[e] + cw[0][e] * xf[i][e] + cw[1][e] * xf[i + 1][e] + cw[2][e] * xf[i + 2][e] + cw[3][e] * xf[i + 3][e];
          u32x4 w; w.x = cvt_pk_bf16(xc[0], xc[1]); w.y = cvt_pk_bf16(xc[2], xc[3]); w.z = cvt_pk_bf16(xc[4], xc[5]); w.w = cvt_pk_bf16(xc[6], xc[7]);
          *(u32x4*)(lds + L_A + (2 * tgp + i) * AST + cg8 * 16) = w;
          float* xp = xcf + (2 * tgp + i) * 128 + cg8 * 8; *(f32x4*)xp = (f32x4){xc[0], xc[1], xc[2], xc[3]}; *(f32x4*)(xp + 4) = (f32x4){xc[4], xc[5], xc[6], xc[7]};
        } }
      if (ci + 1 < nch) LRU_LOAD(dir ? nch - 2 - ci : ci + 1);
      __syncthreads();
#pragma unroll
      for (int tg = 0; tg < 2; ++tg) { f32x16 acc = {};
#pragma unroll
        for (int ks = 0; ks < 8; ++ks) { const bf16x8 a = *(const bf16x8*)(lds + L_A + (tg * 32 + r32) * AST + ks * 32 + hi * 16);
          acc = __builtin_amdgcn_mfma_f32_32x32x16_bf16(a, bfr[ks], acc, 0, 0, 0); }
#pragma unroll
        for (int r = 0; r < 16; ++r) { const int tok = tg * 32 + dattn::crow(r, hi); G[(gate * CH + tok) * 128 + cgp * 32 + r32] = sigmoidf_(acc[r] + gbias); } }
      __syncthreads();
      unsigned short hfv[16], gyv[16];
      if (dir) { const GAS bf16_t* hp = (const GAS bf16_t*)(hfcol + (size_t)(t0 + CH - 1 - sg * 16) * 1024); const GAS bf16_t* gp = (const GAS bf16_t*)(gcol + (size_t)(t0 + CH - 1 - sg * 16) * 1024);
#pragma unroll
        for (int k = 0; k < 16; ++k) { hfv[k] = *hp; gyv[k] = *gp; hp -= 1024; gp -= 1024; asm volatile("" : "+v"(hp), "+v"(gp)); } }
      float av[16], uv[16]; float Pp = 1.f, Ss = 0.f;
#pragma unroll
      for (int k = 0; k < 16; ++k) { const int p = sg * 16 + k, tl = dir ? CH - 1 - p : p;
        const float r_ = G[tl * 128 + c], i_ = G[(CH + tl) * 128 + c], x_ = xcf[tl * 128 + c];
        const float a = __builtin_amdgcn_exp2f(spl * r_); float mult = __builtin_amdgcn_sqrtf(fmaxf(1.f - a * a, 0.f));
        if (ci == 0 && p == 0) mult = 1.f;
        const float u = mult * i_ * x_; av[k] = a; uv[k] = u; Ss = a * Ss + u; Pp *= a; }
      PS[sg * 128 + c] = (f32x2){Pp, Ss};
      __syncthreads();
      float h = carry, hin = 0.f;
#pragma unroll
      for (int s2 = 0; s2 < 4; ++s2) { const f32x2 ps = PS[s2 * 128 + c]; if (s2 == sg) hin = h; h = ps[0] * h + ps[1]; }
      carry = h; h = hin;
      if (dir == 0) { GAS bf16_t* hp = (GAS bf16_t*)(hfcol + (size_t)(t0 + sg * 16) * 1024);
#pragma unroll
        for (int k = 0; k < 16; ++k) { h = av[k] * h + uv[k]; *hp = (bf16_t)(cvt_pk_bf16(h, 0.f) & 0xffffu); hp += 1024; asm volatile("" : "+v"(hp)); }
      } else { GAS bf16_t* lp = (GAS bf16_t*)(locol + (size_t)(t0 + CH - 1 - sg * 16) * 2048);
#pragma unroll
        for (int k = 0; k < 16; ++k) { h = av[k] * h + uv[k];
          *lp = (bf16_t)(cvt_pk_bf16((h + bf2f(hfv[k])) * bf2f(gyv[k]), 0.f) & 0xffffu); lp -= 2048; asm volatile("" : "+v"(lp)); }
      }
    }
    asm volatile("s_waitcnt vmcnt(0)" ::: "memory");
    __syncthreads();
#undef LRU_LOAD
  }
}
}

__device__ __forceinline__ unsigned pk2(float lo, float hi) { return cvt_pk_bf16(lo, hi); }
__device__ __forceinline__ void transpose_item(const float* W, int K, int N, bf16_t* WT, int k0, int n0, int drow0, LAS float* scr, int lane, int ldk = 0, int koff = 0) {
    if (ldk == 0) ldk = K;
#pragma unroll 8
    for (int i = 0; i < 32; ++i) { const int kk = 2 * i + (lane >> 5); scr[kk * 33 + (lane & 31)] = W[(size_t)(k0 + kk) * N + n0 + (lane & 31)]; }
    asm volatile("s_waitcnt lgkmcnt(0)" ::: "memory");
    const int c = lane & 7;
#pragma unroll
    for (int j = 0; j < 4; ++j) { const int n = (lane >> 3) + 8 * j; const LAS float* s = scr + (8 * c) * 33 + n;
        u32x4 o; o.x = pk2(s[0 * 33], s[1 * 33]); o.y = pk2(s[2 * 33], s[3 * 33]); o.z = pk2(s[4 * 33], s[5 * 33]); o.w = pk2(s[6 * 33], s[7 * 33]);
        *(u32x4*)(WT + (size_t)(drow0 + n) * ldk + koff + k0 + 8 * c) = o; }
    asm volatile("s_waitcnt lgkmcnt(0)" ::: "memory");
}
__device__ __forceinline__ int ffin_row(int n) { return n < DFF ? (n >> 7) * 256 + (n & 127) : ((n - DFF) >> 7) * 256 + 128 + ((n - DFF) & 127); }
__device__ __forceinline__ void cvt_rows(const float* src, bf16_t* dst, size_t n8, size_t gtid, size_t gthreads) {
    for (size_t i = gtid; i < n8; i += gthreads) { const f32x4 a = *(const f32x4*)(src + i * 8), b = *(const f32x4*)(src + i * 8 + 4);
        u32x4 w; w.x = pk2(a[0], a[1]); w.y = pk2(a[2], a[3]); w.z = pk2(b[0], b[1]); w.w = pk2(b[2], b[3]); *(u32x4*)(dst + i * 8) = w; }
}
__device__ __forceinline__ void ln_row(const float* yrow, const float* g, const float* b, float* of, bf16_t* ob, int lane) {
    f32x4 v[4]; float s = 0.f;
#pragma unroll
    for (int j = 0; j < 4; ++j) { v[j] = *(const f32x4*)(yrow + 256 * j + 4 * lane); s += (v[j][0] + v[j][1]) + (v[j][2] + v[j][3]); }
    const float mean = wave_sum(s) * (1.f / 1024.f); float s2 = 0.f;
#pragma unroll
    for (int j = 0; j < 4; ++j) { v[j] = v[j] - mean; s2 += (v[j][0] * v[j][0] + v[j][1] * v[j][1]) + (v[j][2] * v[j][2] + v[j][3] * v[j][3]); }
    const float rstd = rsqrtf(wave_sum(s2) * (1.f / 1024.f) + LN_EPS);
#pragma unroll
    for (int j = 0; j < 4; ++j) { const f32x4 gg = *(const f32x4*)(g + 256 * j + 4 * lane), bb = *(const f32x4*)(b + 256 * j + 4 * lane);
        const f32x4 o = v[j] * rstd * gg + bb; *(f32x4*)(of + 256 * j + 4 * lane) = o;
        if (ob) { u32x2 w; w.x = pk2(o[0], o[1]); w.y = pk2(o[2], o[3]); *(u32x2*)(ob + 256 * j + 4 * lane) = w; } }
}


#define XB_TMO      128
#define XB_XCNT(j)  (256  + 64 * (j))
#define XB_XSUB(j)  (1280 + 64 * (j))
#define XB_XGEN(j)  (2304 + 64 * (j))
#define XB_TOP      3328
#define XB_TOPGEN   3392
#define XCD_BAR_WORDS 3456
#define XB_SPIN_CAP (1u << 20)
__device__ __forceinline__ unsigned xb_ld(unsigned* p)              { return __hip_atomic_load(p, __ATOMIC_RELAXED, __HIP_MEMORY_SCOPE_AGENT); }
__device__ __forceinline__ unsigned xb_add(unsigned* p, unsigned v) { return __hip_atomic_fetch_add(p, v, __ATOMIC_RELAXED, __HIP_MEMORY_SCOPE_AGENT); }
__device__ __forceinline__ unsigned xb_xcc_id() { return (unsigned)__builtin_amdgcn_s_getreg((3 << 11) | 20) & 0xFu; }
#define XB_SPIN(cond, bar) do { unsigned _sp = 0; while (cond) { __builtin_amdgcn_s_sleep(1); \
    if ((++_sp & 255u) == 0u) { if (xb_ld(&(bar)[XB_TMO])) break; if (_sp > XB_SPIN_CAP) { atomicAdd(&(bar)[XB_TMO], 1u); break; } } } } while (0)
struct XcdBarrier { unsigned* bar; unsigned x; volatile LAS unsigned* st; };
__device__ __forceinline__ XcdBarrier xcd_barrier_post(unsigned* bar, volatile LAS unsigned* st) {
    XcdBarrier b; b.bar = bar; b.x = xb_xcc_id(); b.st = st;
    if (threadIdx.x == 0) (void)xb_add(&bar[XB_XCNT(b.x)], 1u);
    return b;
}
__device__ __forceinline__ void xcd_barrier_complete(unsigned* bar, unsigned x, unsigned& nloc, unsigned& nx) {
    const unsigned G = gridDim.x * gridDim.y * gridDim.z;
    unsigned sum, cnt, mine, sp = 0u;
    for (;;) {
        sum = 0u; cnt = 0u; mine = 0u;
#pragma unroll
        for (unsigned j = 0; j < 16; ++j) { const unsigned c = xb_ld(&bar[XB_XCNT(j)]); sum += c; cnt += (c > 0u) ? 1u : 0u; mine = (j == x) ? c : mine; }
        if (sum == G) break;
        __builtin_amdgcn_s_sleep(1);
        if ((++sp & 255u) == 0u) { if (xb_ld(&bar[XB_TMO])) break; if (sp > XB_SPIN_CAP) { atomicAdd(&bar[XB_TMO], 1u); break; } }
    }
    nloc = mine > 0u ? mine : 1u; nx = cnt > 0u ? cnt : 1u;
}
__device__ __forceinline__ void xcd_barrier(const XcdBarrier& b) {
    asm volatile("s_waitcnt vmcnt(0)" ::: "memory");
    __syncthreads();
    if (threadIdx.x == 0) {
        unsigned* bar = b.bar;
        __builtin_amdgcn_s_waitcnt(0);
        unsigned nloc = b.st[0], nx = b.st[1];
        if (nloc == 0u) { xcd_barrier_complete(bar, b.x, nloc, nx); b.st[0] = nloc; b.st[1] = nx; }
        const unsigned old = xb_add(&bar[XB_XSUB(b.x)], 1u);
        const unsigned gen = old / nloc;
        if (old + 1u == (gen + 1u) * nloc) {
            __builtin_amdgcn_fence(__ATOMIC_RELEASE, "agent");
            asm volatile("s_waitcnt vmcnt(0)" ::: "memory");
            const unsigned og = xb_add(&bar[XB_TOP], 1u);
            const unsigned tg = og / nx;
            if (og + 1u == (tg + 1u) * nx) xb_add(&bar[XB_TOPGEN], 1u);
            else XB_SPIN(xb_ld(&bar[XB_TOPGEN]) == tg, bar);
            __builtin_amdgcn_fence(__ATOMIC_ACQUIRE, "agent");
            xb_add(&bar[XB_XGEN(b.x)], 1u);
            asm volatile("s_waitcnt vmcnt(0)" ::: "memory");
        } else {
            XB_SPIN(xb_ld(&bar[XB_XGEN(b.x)]) == gen, bar);
            __builtin_amdgcn_fence(__ATOMIC_ACQUIRE, "agent");
            asm volatile("s_waitcnt vmcnt(0)" ::: "memory");
        }
    }
    __syncthreads();
}

constexpr size_t WS_PTRS = 8192;
__device__ __forceinline__ const float* inptr(const unsigned char* ws, int i) {
    const GAS unsigned* p = (const GAS unsigned*)(ws + WS_PTRS) + 2 * i;
    const unsigned lo = __builtin_amdgcn_readfirstlane(p[0]), hi = __builtin_amdgcn_readfirstlane(p[1]);
    return (const float*)(const GAS float*)(((unsigned long long)hi << 32) | lo);
}
#ifndef PH_MASK
#define PH_MASK 0xffffffffu
#endif
#define PHON(k) ((PH_MASK >> (k)) & 1u)
#ifndef REP_MASK
#define REP_MASK 0u
#endif
#define NREP(k) (1 + (int)((REP_MASK >> (k)) & 1u))
struct Args { const float* in[31]; float* out; unsigned char* ws; int ph_lo, ph_hi; };
enum { I_XP = 0, I_XS, I_MP, I_MS, I_WIN, I_LQ1, I_LK1, I_LQ2, I_LK2, I_SUBG, I_CONVW, I_CONVB, I_LWA, I_LBA, I_LWX, I_LBX, I_LA, I_PATTN, I_PLRU, I_WMIX,
       I_LN1G, I_LN1B, I_XAQ, I_XAKV, I_XAO, I_LN2G, I_LN2B, I_FFIN, I_FFOUT, I_LN3G, I_LN3B };

__global__ void __launch_bounds__(NTHREADS, 2) mk_fwd(Args args) {
    extern __shared__ __attribute__((aligned(16))) unsigned char lds_raw[];
    cg::grid_group grid = cg::this_grid();
    int phase = 0;
    volatile LAS unsigned* bst = (volatile LAS unsigned*)((LAS unsigned char*)lds_raw + LDS_BYTES - 128);
    if (threadIdx.x < 2) bst[threadIdx.x] = 0u;
    __syncthreads();
    const XcdBarrier xbar = xcd_barrier_post((unsigned*)(args.ws + WS_CTL) + CW_BAR, bst);
#define SEAM() do { ++phase; if (phase > args.ph_lo && phase < args.ph_hi) { if (args.ph_lo < 0) grid.sync(); else xcd_barrier(xbar); } } while (0)
#define ACTIVE() (phase >= args.ph_lo && phase < args.ph_hi)
#define FRESH() LAS unsigned char* lds = (LAS unsigned char*)lds_raw; int tid = threadIdx.x; asm volatile("" : "+v"(tid)); \
    const int lane = tid & 63, wave = __builtin_amdgcn_readfirstlane(tid >> 6); GAS unsigned char* wsg_ = (GAS unsigned char*)args.ws; asm volatile("" : "+s"(wsg_)); unsigned char* ws = (unsigned char*)wsg_; \
    const int G = gridDim.x, bx = blockIdx.x; const size_t gtid = (size_t)bx * NTHREADS + tid, gthreads = (size_t)G * NTHREADS; const int gw = bx * NWAVES + wave, NGW = G * NWAVES; \
    (void)lds; (void)lane; (void)wave; (void)gtid; (void)gthreads; (void)gw; (void)NGW;
#define WSP(T, off) ((T*)(ws + (off)))
#define INP(i) inptr(ws, (i))

    if (ACTIVE() && PHON(0)) {
        FRESH();
        unsigned* ctl = WSP(unsigned, WS_CTL); float* rope = WSP(float, WS_ROPE);
        if (bx == 0 && tid < 256) ctl[CW_QUEUE + tid] = 0u;
        if (gtid == 0) { const float** tbl = WSP(const float*, WS_PTRS);
#pragma unroll
            for (int i = 0; i < 31; ++i) tbl[i] = args.in[i]; }
        if (bx == 0 && wave == 1) {
            const float a = wave_sum(args.in[I_LQ1][lane] * args.in[I_LK1][lane]), b = wave_sum(args.in[I_LQ2][lane] * args.in[I_LK2][lane]);
            if (lane == 0) ((float*)ctl)[CW_LAM] = __expf(a) - __expf(b) + LAMBDA_INIT;
        }
        for (size_t i = gtid; i < 8192 * 8; i += gthreads) { const int t = (int)(i >> 3), j = (int)(i & 7);
            const float inv = exp2f(-(float)j * 0.125f * 18.931568569324174f);
            const float ang = (float)t * inv; const double rev = (double)ang * 0.15915494309189535; const float fr = (float)(rev - floor(rev));
            rope[t * 16 + j] = __builtin_amdgcn_cosf(fr); rope[t * 16 + 8 + j] = __builtin_amdgcn_sinf(fr); }
        LAS float* scr = (LAS float*)(lds + wave * 16384);
        int it0 = gw;
#pragma unroll 1
        for (int jb = 0; jb < 9; ++jb) {
            const float* W; int K = 1024, N = 1024; bf16_t* WT; int kind = 0, ldk = 0, koff = 0;
            switch (jb) {
                case 0: W = args.in[I_WIN]; N = INW; WT = WSP(bf16_t, WS_WIN); break;
                case 1: W = args.in[I_PATTN]; WT = WSP(bf16_t, WS_PATTN); ldk = 2048; break;
                case 2: W = args.in[I_PLRU]; WT = WSP(bf16_t, WS_PATTN); ldk = 2048; koff = 1024; break;
                case 3: W = args.in[I_WMIX]; WT = WSP(bf16_t, WS_WMIX); break;
                case 4: W = args.in[I_XAQ]; WT = WSP(bf16_t, WS_XAQ); break;
                case 5: W = args.in[I_XAO]; WT = WSP(bf16_t, WS_XAO); break;
                case 6: W = args.in[I_XAKV]; N = 2048; WT = WSP(bf16_t, WS_XAKV); break;
                case 7: W = args.in[I_FFIN]; N = 2 * DFF; WT = WSP(bf16_t, WS_FFIN); kind = 1; break;
                default: W = args.in[I_FFOUT]; K = DFF; WT = WSP(bf16_t, WS_FFOUT); break;
            }
            const int nblk = N / 32, nit = (K / 64) * nblk;
#pragma unroll 1
            for (; it0 < nit; it0 += NGW) { const int kb = it0 / nblk, nbk = it0 % nblk, n0 = 32 * nbk;
                transpose_item(W, K, N, WT, 64 * kb, n0, kind ? ffin_row(n0) : n0, scr, lane, ldk, koff); }
            it0 -= nit; }
#pragma unroll 1
        for (int it = gw; it < 32 * 8; it += NGW) { const int mat = it >> 3, sub = it & 7, kb = sub >> 2, nbk = sub & 3;
            const int dir = mat >> 4, gate = (mat >> 3) & 1, nb = mat & 7;
            const float* src = (gate == 0 ? args.in[I_LWA] : args.in[I_LWX]) + (size_t)(dir * 8 + nb) * 16384;
            transpose_item(src, 128, 128, WSP(bf16_t, WS_LRUW) + (size_t)mat * 16384, 64 * kb, 32 * nbk, 32 * nbk, scr, lane); }
        cvt_rows(args.in[I_XP], WSP(bf16_t, WS_XB), (size_t)RM * 1024 / 8, gtid, gthreads);
        cvt_rows(args.in[I_XS], WSP(bf16_t, WS_XB) + (size_t)RM * 1024, (size_t)2 * RM * 1024 / 8, gtid, gthreads);
        cvt_rows(args.in[I_MP], WSP(bf16_t, WS_MEMB), (size_t)1024 * 1024 / 8, gtid, gthreads);
        cvt_rows(args.in[I_MS], WSP(bf16_t, WS_MEMB) + (size_t)1024 * 1024, (size_t)8192 * 1024 / 8, gtid, gthreads);
    }
    SEAM();

#pragma unroll 1
    for (int r = 0; r < NROUND; ++r) {
        const int Tseq = r == 0 ? 8192 : 2048, nseq = RM / Tseq, seq0 = r == 0 ? 0 : 4 + (r - 1) * 16, tsh = r == 0 ? 5 : 3;
#define XIN() (r == 0 ? INP(I_XP) : INP(I_XS) + (size_t)(r - 1) * RM * 1024)
#define OUTR() (args.out + (size_t)r * RM * 1024)

        if (ACTIVE() && PHON(1)) {
            FRESH();
            for (int rep = 0; rep < NREP(1); ++rep)
            { pg8::Gemm g{WSP(bf16_t, WS_XB) + (size_t)r * RM * 1024, WSP(bf16_t, WS_WIN), 1024, 1024, 1024}; pg8::StaticOrder S; S.init(RM, INW, G, bx);
              pg8::EpiProj E{WSP(bf16_t, WS_Q), WSP(float, WS_ROPE), Tseq - 1}; pg8::gemm_phase(lds, g, S, E); }
            if (r == 0) { pg8::Gemm g{WSP(bf16_t, WS_MEMB), WSP(bf16_t, WS_XAKV), 1024, 1024, 1024}; pg8::StaticOrder S; S.init(NMEMROW, 2048, G, bx);
              pg8::EpiKV E{WSP(bf16_t, WS_KX), WSP(bf16_t, WS_VXT)}; pg8::gemm_phase(lds, g, S, E); }
        }
        SEAM();
        if (ACTIVE() && PHON(2)) {
            FRESH();
            unsigned* ctl = WSP(unsigned, WS_CTL);
            const int nlru = nseq * 8, qpb = Tseq / 128, natt = nseq * 8 * qpb;
            LAS int* qslot = (LAS int*)(lds + LDS_BYTES - 64);
            if (PHON(16)) {
                const lru::Params LP{WSP(bf16_t, WS_XR), (bf16_t*)OUTR(), WSP(bf16_t, WS_GYR), WSP(bf16_t, WS_AOLO), WSP(bf16_t, WS_LRUW), INP(I_CONVW), INP(I_CONVB), INP(I_LBA), INP(I_LBX), INP(I_LA)};
                for (int rep = 0; rep < NREP(16); ++rep) for (;;) {
                    if (tid == 0) *qslot = (int)atomicAdd(ctl + CW_QUEUE + 64 * r + 8 * rep, 1u);
                    __syncthreads();
                    const int u = __builtin_amdgcn_readfirstlane(*qslot);
                    __syncthreads();
                    if (u >= nlru) break;
                    lru::unit(LP, u, Tseq, (char*)lds_raw);
                }
            }
            if (PHON(17)) {
                const float lam = ((const float*)ctl)[CW_LAM];
                const bf16_t* qb = WSP(bf16_t, WS_Q); const bf16_t* kb_ = WSP(bf16_t, WS_K); const bf16_t* vb = WSP(bf16_t, WS_V); bf16_t* aolo = WSP(bf16_t, WS_AOLO);
                for (int rep = 0; rep < NREP(17); ++rep) {
                    unsigned* qctr = ctl + CW_QUEUE + 64 * r + 32 + 8 * rep;
                    if (tid == 0) *qslot = (int)atomicAdd(qctr, 1u);
                    __syncthreads();
                    int a = __builtin_amdgcn_readfirstlane(*qslot);
                    while (a < natt) {
                        int pend = 0; if (tid == 0) pend = (int)atomicAdd(qctr, 1u);
                        const int qi = a % qpb, hh = (a / qpb) & 7, sq = a / (qpb * 8);
                        const size_t row0 = (size_t)sq * Tseq;
                        dattn::unit(qb + (row0 + (size_t)qi * 128) * 1024 + hh * 128, kb_ + row0 * 1024 + hh * 128, vb + row0 * 1024 + hh * 128,
                                    aolo + (row0 + (size_t)qi * 128) * 2048 + hh * 128, 2048, Tseq, (char*)lds_raw, lam, INP(I_SUBG), pend, qslot);
                        a = __builtin_amdgcn_readfirstlane(*qslot);
                    }
                    __syncthreads();
                }
            }
        }
        SEAM();
        if (ACTIVE() && PHON(4)) for (int rep = 0; rep < NREP(4); ++rep) {
            FRESH();
            pg8::Gemm g{WSP(bf16_t, WS_AOLO), WSP(bf16_t, WS_PATTN), 2048, 2048, 2048}; pg8::StaticOrder S; S.init(RM, 1024, G, bx);
            pg8::EpiGateCat E{WSP(bf16_t, WS_SA), WSP(bf16_t, WS_SL), WSP(bf16_t, WS_MERGED)}; pg8::gemm_phase<true>(lds, g, S, E);
        }
        SEAM();
        if (ACTIVE() && PHON(5)) { FRESH(); pg8::Gemm g{WSP(bf16_t, WS_MERGED), WSP(bf16_t, WS_WMIX), 1024, 1024, 1024}; pg8::StaticOrder S; S.init(RM, 1024, G, bx);
            pg8::EpiResidLN<true> E{XIN(), WSP(float, WS_Y), WSP(bf16_t, WS_X1B), INP(I_LN1G), INP(I_LN1B), {WSP(unsigned long long, WS_LNX), WSP(unsigned, WS_CTL) + CW_LNCNT + ((r * 3 + 0) * 128) * 16}, lds + XLDS_OFF};
            pg8::gemm_phase(lds, g, S, E); }
        SEAM();
        if (ACTIVE() && PHON(7)) { FRESH();
            { pg8::Gemm g{WSP(bf16_t, WS_X1B), WSP(bf16_t, WS_XAQ), 1024, 1024, 1024}; pg8::PmPnOrder S{(RM / 256) * 4, G, bx}; pg8::EpiBf16 E{WSP(bf16_t, WS_QX), 1024, 0.0625f}; pg8::gemm_phase(lds, g, S, E); }
            { pg8::Gemm g{WSP(bf16_t, WS_QX), WSP(bf16_t, WS_KX), 1024, 1024, 256}; pg8::XaOrder<0> S{(RM / 256) * 4, G, bx, tsh, seq0};
              pg8::EpiSoftmax E{WSP(bf16_t, WS_P), (LAS float*)(lds + XLDS_OFF)}; pg8::gemm_phase(lds, g, S, E); }
            { pg8::Gemm g{WSP(bf16_t, WS_P), WSP(bf16_t, WS_VXT), 1024, 256, 256}; pg8::XaOrder<1> S{(RM / 256) * 4, G, bx, tsh, seq0};
              pg8::EpiBf16 E{WSP(bf16_t, WS_OXA), 1024, 1.f}; pg8::gemm_phase(lds, g, S, E); }
        }
        SEAM();
        if (ACTIVE() && PHON(10)) { FRESH(); pg8::Gemm g{WSP(bf16_t, WS_OXA), WSP(bf16_t, WS_XAO), 1024, 1024, 1024}; pg8::StaticOrder S; S.init(RM, 1024, G, bx);
            pg8::EpiResidLN<true> E{WSP(float, WS_Y), WSP(float, WS_Y), WSP(bf16_t, WS_X2B), INP(I_LN2G), INP(I_LN2B), {WSP(unsigned long long, WS_LNX), WSP(unsigned, WS_CTL) + CW_LNCNT + ((r * 3 + 1) * 128) * 16}, lds + XLDS_OFF};
            pg8::gemm_phase(lds, g, S, E); }
        SEAM();
        if (ACTIVE() && PHON(12)) for (int rep = 0; rep < NREP(12); ++rep) { FRESH(); pg8::Gemm g{WSP(bf16_t, WS_X2B), WSP(bf16_t, WS_FFIN), 1024, 1024, 1024}; pg8::StaticOrder S; S.init(RM, 2 * DFF, G, bx); pg8::EpiSwiglu E{WSP(bf16_t, WS_HFF)}; pg8::gemm_phase(lds, g, S, E); }
        SEAM();
        if (ACTIVE() && PHON(13)) { FRESH(); pg8::Gemm g{WSP(bf16_t, WS_HFF), WSP(bf16_t, WS_FFOUT), DFF, DFF, DFF}; pg8::StaticOrder S; S.init(RM, 1024, G, bx);
            pg8::EpiResidLN<false> E{WSP(float, WS_Y), OUTR(), nullptr, INP(I_LN3G), INP(I_LN3B), {WSP(unsigned long long, WS_LNX), WSP(unsigned, WS_CTL) + CW_LNCNT + ((r * 3 + 2) * 128) * 16}, lds + XLDS_OFF};
            pg8::gemm_phase(lds, g, S, E); }
        SEAM();
    }
#undef SEAM
#undef ACTIVE
}

extern "C" void kernel_launch(void* const* d_in, const int* in_sizes, int n_in, void* d_out, int out_size, void* d_ws, size_t ws_size, hipStream_t stream) {
    static int grid = 0;
    if (grid == 0) {
        if (n_in != 31 || out_size != NTOK * 1024 || ws_size < WS_END) { fprintf(stderr, "kernel_launch: unexpected shapes n_in %d out %d ws %zu\n", n_in, out_size, ws_size); grid = -1; return; }
        int dev = 0, cus = 0, per_cu = 0;
        hipGetDevice(&dev); hipDeviceGetAttribute(&cus, hipDeviceAttributeMultiprocessorCount, dev);
        if (hipFuncSetAttribute((const void*)mk_fwd, hipFuncAttributeMaxDynamicSharedMemorySize, LDS_BYTES) != hipSuccess) { fprintf(stderr, "kernel_launch: hipFuncSetAttribute failed\n"); grid = -1; return; }
        hipOccupancyMaxActiveBlocksPerMultiprocessor(&per_cu, (const void*)mk_fwd, NTHREADS, LDS_BYTES);
        (void)hipGetLastError();
        if (per_cu < 1) per_cu = 1;
        grid = cus * 1;
        fprintf(stderr, "kernel_launch: cus %d per_cu %d grid %d\n", cus, per_cu, grid);
    }
    if (grid < 0) return;
    if (hipMemsetAsync((char*)d_ws + WS_CTL, 0, CTL_ZERO_BYTES, stream) != hipSuccess) { fprintf(stderr, "kernel_launch: memset failed\n"); return; }
    Args a{};
    for (int i = 0; i < 31; ++i) a.in[i] = (const float*)d_in[i];
    a.out = (float*)d_out; a.ws = (unsigned char*)d_ws; a.ph_lo = 0; a.ph_hi = 1000;
    void* kargs[] = {&a};
    hipError_t e = hipLaunchCooperativeKernel((const void*)mk_fwd, dim3(grid), dim3(NTHREADS), kargs, LDS_BYTES, stream);
    if (e != hipSuccess) fprintf(stderr, "kernel_launch: cooperative launch failed: %s (grid %d)\n", hipGetErrorString(e), grid);
}
```
